# Optimizing an MI355X kernel written in HIP

```python
import math
import jax, jax.numpy as jnp
from jax import lax
import numpy as np

D_MODEL = 2048
BATCH = 2
SEQ = 4096
DEPTH = 1

N_META = 16
EPS = 1e-6
M_HEADS = 4
M_WIDTH = D_MODEL // 2
M_HEAD_DIM = M_WIDTH // M_HEADS
M_GATES = 4 * M_HEADS
M_CHUNK = 64
M_CONV = 3
PAD_LOG_I = -30.0
D_HEADS = 8
D_V_DIM = (D_MODEL // 2) // D_HEADS
D_QK_DIM = D_V_DIM // 2
D_WIDTH = D_HEADS * D_V_DIM
D_QK_WIDTH = D_HEADS * 2 * D_QK_DIM
Q_BLOCK = 128
ROPE_THETA = 500000.0
ROPE_DIM = D_QK_DIM // 4
N_BRANCH = 2
IN_WIDTH = 4 * M_WIDTH + M_GATES + 2 * D_QK_WIDTH + D_WIDTH + N_BRANCH * D_MODEL
FFN_DIM = 11 * D_MODEL // 4
FFN_CONV = 3

kernel_name = "hybrid_mlstm_diffattn_gated_merge"


def rmsnorm(x, g):
    xf = x.astype(jnp.float32)
    r = lax.rsqrt(jnp.mean(xf * xf, axis=-1, keepdims=True) + EPS)
    return (xf * r).astype(x.dtype) * g


def dwconv_centred(x, w):
    xp = jnp.pad(x, ((0, 0), (1, 1), (0, 0)))
    return xp[:, :-2] * w[0] + xp[:, 1:-1] * w[1] + xp[:, 2:] * w[2]


def rope_tables(L, dtype):
    inv_freq = ROPE_THETA ** (-jnp.arange(0, ROPE_DIM, 2, dtype=jnp.float32) / ROPE_DIM)
    ang = jnp.arange(L, dtype=jnp.float32)[:, None] * inv_freq[None, :]
    return jnp.cos(ang).astype(dtype), jnp.sin(ang).astype(dtype)


def rope_partial(x, cos, sin):
    half = ROPE_DIM // 2
    x1 = x[..., :half]
    x2 = x[..., half:ROPE_DIM]
    return jnp.concatenate([x1 * cos - x2 * sin, x2 * cos + x1 * sin, x[..., ROPE_DIM:]], axis=-1)


def mlstm_chunk_step(carry, inp):
    C, n, m = carry
    q, k, v, li, lf = inp
    T = q.shape[-2]
    lower = jnp.tril(jnp.ones((T, T), dtype=bool))
    b = jnp.cumsum(lf, axis=-1)
    g = b[..., -1]
    dmat = jnp.where(lower, b[..., :, None] - b[..., None, :] + li[..., None, :], -jnp.inf)
    inter = b + m[..., None]
    m_t = jnp.maximum(inter, jnp.max(dmat, axis=-1))
    s = jnp.einsum('bhtd,bhsd->bhts', q, k) * jnp.exp(dmat - m_t[..., None])
    a_t = jnp.exp(inter - m_t)
    num = jnp.einsum('bhts,bhsv->bhtv', s, v) + a_t[..., None] * jnp.einsum('bhvd,bhtd->bhtv', C, q)
    den = jnp.sum(s, axis=-1) + a_t * jnp.einsum('bhd,bhtd->bht', n, q)
    h = num / jnp.maximum(jnp.abs(den), jnp.exp(-m_t))[..., None]
    wlog = g[..., None] - b + li
    m_new = jnp.maximum(g + m, jnp.max(wlog, axis=-1))
    decay = jnp.exp(g + m - m_new)
    w = jnp.exp(wlog - m_new[..., None])
    C = decay[..., None, None] * C + jnp.einsum('bhs,bhsv,bhsd->bhvd', w, v, k)
    n = decay[..., None] * n + jnp.einsum('bhs,bhsd->bhd', w, k)
    return (C, n, m_new), h


def mlstm_scan(q, k, v, li, lf):
    B, H, Lp, dk = q.shape
    dv = v.shape[-1]
    nc = Lp // M_CHUNK

    def chunks(t):
        return jnp.moveaxis(t.reshape(t.shape[:2] + (nc, M_CHUNK) + t.shape[3:]), 2, 0)

    init = (jnp.zeros((B, H, dv, dk), jnp.float32), jnp.zeros((B, H, dk), jnp.float32),
            jnp.zeros((B, H), jnp.float32))
    _, h = lax.scan(mlstm_chunk_step, init, (chunks(q), chunks(k), chunks(v), chunks(li), chunks(lf)))
    return jnp.moveaxis(h, 0, 2).reshape(B, H, Lp, dv)


def mlstm_branch(m_qk, m_v, m_o, m_gates, conv_w, gate_bias, norm_g):
    B, L, _ = m_qk.shape
    dtype = m_qk.dtype
    qk = jax.nn.silu(dwconv_centred(m_qk, conv_w))
    q, k = jnp.split(qk, 2, axis=-1)

    def heads(t):
        return t.reshape(B, L, M_HEADS, M_HEAD_DIM).transpose(0, 2, 1, 3).astype(jnp.float32)

    q = heads(q)
    k = heads(k) * (M_HEAD_DIM ** -0.5)
    v = heads(m_v)
    gates = (m_gates + gate_bias).astype(jnp.float32).transpose(0, 2, 1)
    li_f = gates[:, 0:M_HEADS]
    lf_f = jax.nn.log_sigmoid(gates[:, M_HEADS:2 * M_HEADS])
    li_b = gates[:, 2 * M_HEADS:3 * M_HEADS]
    lf_b = jax.nn.log_sigmoid(gates[:, 3 * M_HEADS:4 * M_HEADS])
    pad = (-N_META) % M_CHUNK

    def padl(t, val):
        return jnp.pad(t, ((0, 0), (0, 0), (pad, 0)) + ((0, 0),) * (t.ndim - 3), constant_values=val)

    def flip(t):
        return jnp.flip(t, axis=2)

    qp, kp, vp = padl(q, 0.0), padl(k, 0.0), padl(v, 0.0)
    h_fwd = mlstm_scan(qp, kp, vp, padl(li_f, PAD_LOG_I), padl(lf_f, 0.0))
    h_bwd = flip(mlstm_scan(flip(qp), flip(kp), flip(vp), flip(padl(li_b, PAD_LOG_I)), flip(padl(lf_b, 0.0))))
    hs = (h_fwd + h_bwd)[:, :, pad:]
    mu = jnp.mean(hs, axis=-1, keepdims=True)
    var = jnp.mean(jnp.square(hs - mu), axis=-1, keepdims=True)
    hn = (hs - mu) * lax.rsqrt(var + EPS)
    hn = hn.astype(dtype) * norm_g.reshape(M_HEADS, 1, M_HEAD_DIM)
    hn = hn.transpose(0, 2, 1, 3).reshape(B, L, M_WIDTH)
    return jax.nn.sigmoid(m_o) * hn


def diff_attention_branch(d_q, d_k, d_v, lq1, lk1, lq2, lk2, subln_g, lam_init, cos, sin):
    B, L, _ = d_q.shape
    q = d_q.reshape(B, L, D_HEADS, 2, D_QK_DIM).transpose(0, 2, 3, 1, 4)
    k = d_k.reshape(B, L, D_HEADS, 2, D_QK_DIM).transpose(0, 2, 3, 1, 4)
    v = d_v.reshape(B, L, D_HEADS, D_V_DIM).transpose(0, 2, 1, 3)
    q = rope_partial(q, cos, sin)
    k = rope_partial(k, cos, sin)
    lam = (jnp.exp(jnp.sum(lq1.astype(jnp.float32) * lk1.astype(jnp.float32)))
           - jnp.exp(jnp.sum(lq2.astype(jnp.float32) * lk2.astype(jnp.float32))) + lam_init)
    LQ = -(-L // Q_BLOCK) * Q_BLOCK
    nb = LQ // Q_BLOCK
    qpad = jnp.pad(q, ((0, 0), (0, 0), (0, 0), (0, LQ - L), (0, 0)))
    qb = jnp.moveaxis(qpad.reshape(B, D_HEADS, 2, nb, Q_BLOCK, D_QK_DIM), 3, 0)
    scale = D_QK_DIM ** -0.5

    def attend(qblk):
        s = jnp.einsum('bhmqd,bhmkd->bhmqk', qblk, k).astype(jnp.float32) * scale
        p = jax.nn.softmax(s, axis=-1)
        a = p[:, :, 0] - lam * p[:, :, 1]
        return jnp.einsum('bhqk,bhkd->bhqd', a.astype(v.dtype), v)

    o = lax.map(attend, qb)
    o = jnp.moveaxis(o, 0, 2).reshape(B, D_HEADS, LQ, D_V_DIM)[:, :, :L]
    o = rmsnorm(o, subln_g) * (1.0 - lam_init)
    return o.transpose(0, 2, 1, 3).reshape(B, L, D_WIDTH)


def setup_inputs(seed: int = 0) -> dict:
    key = jax.random.key(seed)
    ks = jax.random.split(key, 24)
    f32 = jnp.float32

    def nrm(k, shape, scale):
        return jax.random.normal(k, shape, f32) * scale

    def gain(k, shape):
        return 1.0 + 0.02 * jax.random.normal(k, shape, f32)

    gk = jax.random.split(ks[5], 4)
    i_f = nrm(gk[0], (DEPTH, M_HEADS), 0.1)
    f_f = jnp.linspace(3.0, 6.0, M_HEADS, dtype=f32)[None] + nrm(gk[1], (DEPTH, M_HEADS), 0.1)
    i_b = nrm(gk[2], (DEPTH, M_HEADS), 0.1)
    f_b = jnp.linspace(3.0, 6.0, M_HEADS, dtype=f32)[None] + nrm(gk[3], (DEPTH, M_HEADS), 0.1)
    return {
        "x": nrm(ks[0], (BATCH, SEQ, D_MODEL), 1.0),
        "meta_tokens": nrm(ks[1], (N_META, D_MODEL), 1.0),
        "norm1_g": gain(ks[2], (DEPTH, D_MODEL)),
        "w_in": nrm(ks[3], (DEPTH, D_MODEL, IN_WIDTH), D_MODEL ** -0.5),
        "mlstm_conv_w": nrm(ks[4], (DEPTH, M_CONV, 2 * M_WIDTH), M_CONV ** -0.5),
        "mlstm_gate_bias": jnp.concatenate([i_f, f_f, i_b, f_b], axis=-1),
        "mlstm_norm_g": gain(ks[6], (DEPTH, M_WIDTH)),
        "lambda_q1": nrm(ks[7], (DEPTH, D_QK_DIM), 0.1),
        "lambda_k1": nrm(ks[8], (DEPTH, D_QK_DIM), 0.1),
        "lambda_q2": nrm(ks[9], (DEPTH, D_QK_DIM), 0.1),
        "lambda_k2": nrm(ks[10], (DEPTH, D_QK_DIM), 0.1),
        "diff_subln_g": gain(ks[11], (DEPTH, D_V_DIM)),
        "w_branch_m": nrm(ks[12], (DEPTH, M_WIDTH, D_MODEL), M_WIDTH ** -0.5),
        "w_branch_d": nrm(ks[13], (DEPTH, D_WIDTH, D_MODEL), D_WIDTH ** -0.5),
        "w_out": nrm(ks[14], (DEPTH, D_MODEL, D_MODEL), D_MODEL ** -0.5),
        "norm2_g": gain(ks[15], (DEPTH, D_MODEL)),
        "w_up": nrm(ks[16], (DEPTH, D_MODEL, 2 * FFN_DIM), D_MODEL ** -0.5),
        "ffn_conv_w": nrm(ks[17], (DEPTH, FFN_CONV, 2 * FFN_DIM), FFN_CONV ** -0.5),
        "w_down": nrm(ks[18], (DEPTH, FFN_DIM, D_MODEL), FFN_DIM ** -0.5),
        "norm_f_g": gain(ks[19], (D_MODEL,)),
    }


def reference(x, meta_tokens, norm1_g, w_in, mlstm_conv_w, mlstm_gate_bias, mlstm_norm_g,
              lambda_q1, lambda_k1, lambda_q2, lambda_k2, diff_subln_g, w_branch_m, w_branch_d,
              w_out, norm2_g, w_up, ffn_conv_w, w_down, norm_f_g):
    B = x.shape[0]
    meta = jnp.broadcast_to(meta_tokens[None].astype(x.dtype), (B, N_META, D_MODEL))
    h = jnp.concatenate([meta, x], axis=1)
    L = h.shape[1]
    cos, sin = rope_tables(L, x.dtype)
    split_at = np.cumsum([2 * M_WIDTH, M_WIDTH, M_WIDTH, M_GATES, D_QK_WIDTH, D_QK_WIDTH,
                          D_WIDTH, D_MODEL]).tolist()
    for layer in range(DEPTH):
        lam_init = 0.8 - 0.6 * math.exp(-0.3 * layer)
        u = rmsnorm(h, norm1_g[layer])
        proj = u @ w_in[layer]
        m_qk, m_v, m_o, m_gates, d_q, d_k, d_v, g_m, g_d = jnp.split(proj, split_at, axis=-1)
        a_out = mlstm_branch(m_qk, m_v, m_o, m_gates, mlstm_conv_w[layer],
                             mlstm_gate_bias[layer], mlstm_norm_g[layer])
        b_out = diff_attention_branch(d_q, d_k, d_v, lambda_q1[layer], lambda_k1[layer],
                                      lambda_q2[layer], lambda_k2[layer], diff_subln_g[layer],
                                      lam_init, cos, sin)
        merged = (jax.nn.sigmoid(g_m) * (a_out @ w_branch_m[layer])
                  + jax.nn.sigmoid(g_d) * (b_out @ w_branch_d[layer]))
        h = h + merged @ w_out[layer]
        up = dwconv_centred(rmsnorm(h, norm2_g[layer]) @ w_up[layer], ffn_conv_w[layer])
        gate, val = jnp.split(up, 2, axis=-1)
        h = h + (jax.nn.silu(gate) * val) @ w_down[layer]
    return rmsnorm(h, norm_f_g)[:, N_META:]
```

```cpp
#include <hip/hip_runtime.h>
#include <cstdio>
#include <cstdint>
#include <cmath>

constexpr int D = 2048, NB = 2, SEQ = 4096, NMETA = 16, L = SEQ + NMETA, NR = NB * L, NX = NB * SEQ, MP = 8448;
constexpr int MH = 4, DH = 8;
constexpr int INW = 11280, PW = 11264, FFN = 5632;
constexpr float EPS = 1e-6f;
constexpr int C_G = 4096;
constexpr int P_MQK = 0, P_MV = 2048, P_MO = 3072, P_DQ = 4096, P_DK = 5120, P_DV = 6144, P_GM = 7168, P_GD = 9216;
__host__ __device__ __forceinline__ int rowof(int b, int p) { return p >= NMETA ? b * SEQ + (p - NMETA) : NX + b * NMETA + p; }
__device__ __forceinline__ void row2bp(int row, int& b, int& p) { if (row < NX) { b = row / SEQ; p = row % SEQ + NMETA; } else { b = ((row - NX) / NMETA) & 1; p = (row - NX) % NMETA; } }

namespace pg8 {
#define PG8_LAS __attribute__((address_space(3)))
typedef unsigned short bf16_t;
typedef short bf16x8 __attribute__((ext_vector_type(8)));
typedef float f32x4 __attribute__((ext_vector_type(4)));
typedef unsigned u32x4 __attribute__((ext_vector_type(4)));
constexpr int BM = 256, BK = 64, HALF = 128, HTB = HALF * BK * 2  , STAGE_BYTES = 8 * HTB, NXCD = 8, WGM = 8;

__host__ __device__ __forceinline__ int lds_byte(int r, int c) { const int st = (r >> 4) * 2 + (c >> 5), rr = r & 15, cc = c & 31, ob = rr * 64 + cc * 2; return st * 1024 + (ob ^ (((ob >> 9) & 1) << 5)); }
__host__ __device__ __forceinline__ void stage_rc(int b, int& R, int& C) { const int st = b / 1024, sb = b % 1024, swz = sb ^ (((sb >> 9) & 1) << 5); R = (st >> 1) * 16 + swz / 64; C = (st & 1) * 32 + (swz % 64) / 2; }
__host__ __device__ __forceinline__ int perm32(int rho) { const int n = rho >> 4, i = rho & 15; return 8 * (i >> 2) + 4 * n + (i & 3); }

struct Unit { int pm, pn, sub; };
struct Gemm { const bf16_t* A; const bf16_t* Bt; int M, N, K; const bf16_t* A2; const bf16_t* Bt2; };

struct StaticOrder {
    int nM, nN, nwg, G, c;
    __host__ __device__ void init(int M, int N, int G_, int c_) { nM = M / BM; nN = N / BM; nwg = nM * nN; G = G_; c = c_; }
    __host__ __device__ bool next(int i, Unit& u) const {
        const long L = (long)i * G + c; if (L >= nwg) return false;
        int wgid = (int)L; { const int q = nwg / NXCD, r = nwg % NXCD, xcd = wgid % NXCD, off = wgid / NXCD; wgid = (xcd < r ? xcd * (q + 1) : r * (q + 1) + (xcd - r) * q) + off; }
        const int nig = WGM * nN, gid = wgid / nig, fm = gid * WGM, gsz = (nM - fm) < WGM ? (nM - fm) : WGM;
        u.pm = fm + ((wgid % nig) % gsz); u.pn = (wgid % nig) / gsz; u.sub = 0; return true;
    }
    __device__ __forceinline__ void a_ready(const Unit&) const {}
    __device__ __forceinline__ void done(const Unit&) const {}
};
__device__ __forceinline__ unsigned cvt_pk_bf16(float lo, float hi) { unsigned r; asm volatile("v_cvt_pk_bf16_f32 %0, %1, %2" : "=v"(r) : "v"(lo), "v"(hi)); return r; }
template <class Epi, class Sched, bool ALIGN_EPI = false, bool SP2 = false>
__device__ __forceinline__ void gemm_phase(PG8_LAS unsigned char* lds, const Gemm g, const Sched& S, const Epi& E) {
    const int tid = threadIdx.x, wid = __builtin_amdgcn_readfirstlane(tid >> 6), lane = tid & 63, wr = wid >> 2, wc = wid & 3, fr = lane & 15, fq = lane >> 4;
    const int K = g.K, nt = K / BK;
    unsigned voffA[2], voffB[2];
#pragma unroll
    for (int i = 0; i < 2; ++i) { int R, C; stage_rc(tid * 16 + i * 8192, R, C); const int Rb = Epi::PERM ? ((R & ~31) + perm32(R & 31)) : R;
        voffA[i] = (unsigned)(R * K + C) * 2u; voffB[i] = (unsigned)(Rb * K + C) * 2u; }
    const size_t kstep = (size_t)(BK * 2);
    const size_t hstep = (size_t)HALF * K * 2;
    const size_t tstep = 2 * hstep;
    const unsigned ldsw = (unsigned)wid * 1024u;
    const int aoff = lds_byte(wr * 64 + fr, fq * 8), boff = lds_byte(wc * 32 + fr, fq * 8);
#define PG8_SA(b, h) (((b) * 2 + (h)) * HTB)
#define PG8_SB(b, h) ((4 + (b) * 2 + (h)) * HTB)
#define PG8_STAGE(bufoff, gbase, voff) do { _Pragma("unroll") for (int _i = 0; _i < 2; ++_i) \
        __builtin_amdgcn_global_load_lds((const unsigned*)((const char*)(gbase) + (voff)[_i]), (PG8_LAS unsigned*)(lds + (bufoff) + ldsw + _i * 8192), 16, 0, 0); } while (0)
#define PG8_LDA(dst, b, h) do { _Pragma("unroll") for (int m = 0; m < 4; ++m) _Pragma("unroll") for (int k = 0; k < 2; ++k) dst[m][k] = *(const PG8_LAS bf16x8*)(lds + PG8_SA(b, h) + aoff + m * 2048 + k * 1024); } while (0)
#define PG8_LDB(dst, b, h) do { _Pragma("unroll") for (int n = 0; n < 2; ++n) _Pragma("unroll") for (int k = 0; k < 2; ++k) dst[n][k] = *(const PG8_LAS bf16x8*)(lds + PG8_SB(b, h) + boff + n * 2048 + k * 1024); } while (0)
#define PG8_MMA(ai, bj, At, Bt) do { __builtin_amdgcn_s_setprio(1); _Pragma("unroll") for (int m = 0; m < 4; ++m) _Pragma("unroll") for (int n = 0; n < 2; ++n) _Pragma("unroll") for (int k = 0; k < 2; ++k) \
        acc[ai][bj][m][n] = __builtin_amdgcn_mfma_f32_16x16x32_bf16(Bt[n][k], At[m][k], acc[ai][bj][m][n], 0, 0, 0); __builtin_amdgcn_s_setprio(0); } while (0)
#define PG8_WAIT_V(n) asm volatile("s_waitcnt vmcnt(" #n ")" ::: "memory")
#define PG8_WAIT_L(n) asm volatile("s_waitcnt lgkmcnt(" #n ")" ::: "memory")
#define PG8_BAR __builtin_amdgcn_s_barrier()
#define PG8_SCHED __builtin_amdgcn_sched_barrier(0)
    Unit cur, nxt; int ui = 0;
    if (!S.next(0, cur)) return;
    f32x4 acc[2][2][4][2];
#pragma unroll
    for (int a = 0; a < 2; ++a)
#pragma unroll
        for (int b = 0; b < 2; ++b)
#pragma unroll
            for (int m = 0; m < 4; ++m)
#pragma unroll
                for (int n = 0; n < 2; ++n) acc[a][b][m][n] = (f32x4){0.f, 0.f, 0.f, 0.f};
    bf16x8 At[4][2], B0[2][2], B1[2][2];
    const char* cA = (const char*)(cur.sub ? g.A2 : g.A) + (size_t)cur.pm * tstep; const char* cB = (const char*)(cur.sub ? g.Bt2 : g.Bt) + (size_t)cur.pn * tstep;
    S.a_ready(cur);
    if constexpr (SP2) {
        PG8_STAGE(PG8_SB(0, 0), cB, voffB); PG8_STAGE(PG8_SB(0, 1), cB + hstep, voffB); PG8_STAGE(PG8_SA(0, 0), cA, voffA); PG8_STAGE(PG8_SA(0, 1), cA + hstep, voffA);
        if (wr == 1) PG8_BAR;
        PG8_WAIT_V(2); PG8_BAR;
        PG8_STAGE(PG8_SB(1, 0), cB + kstep, voffB); PG8_STAGE(PG8_SA(1, 0), cA + kstep, voffA); PG8_STAGE(PG8_SB(1, 1), cB + hstep + kstep, voffB);
        PG8_WAIT_V(6); PG8_BAR;
    } else {
        PG8_STAGE(PG8_SB(0, 0), cB, voffB); PG8_STAGE(PG8_SA(0, 0), cA, voffA); PG8_STAGE(PG8_SB(0, 1), cB + hstep, voffB); PG8_STAGE(PG8_SA(0, 1), cA + hstep, voffA);
        if (wr == 1) PG8_BAR;
        PG8_WAIT_V(4); PG8_BAR;
        PG8_STAGE(PG8_SB(1, 0), cB + kstep, voffB); PG8_STAGE(PG8_SA(1, 0), cA + kstep, voffA); PG8_STAGE(PG8_SB(1, 1), cB + hstep + kstep, voffB);
        PG8_WAIT_V(6); PG8_BAR;
    }
    for (;;) {
        const bool has_next = S.next(ui + 1, nxt);
        const char* nA = has_next ? (const char*)(nxt.sub ? g.A2 : g.A) + (size_t)nxt.pm * tstep : cA; const char* nB = has_next ? (const char*)(nxt.sub ? g.Bt2 : g.Bt) + (size_t)nxt.pn * tstep : cB;
        for (int t = 0; t < nt; t += 2) {
            const bool last = (t == nt - 2);
            const char* a1 = cA + (size_t)(t + 1) * kstep;
            const char* a2 = last ? nA : cA + (size_t)(t + 2) * kstep; const char* b2 = last ? nB : cB + (size_t)(t + 2) * kstep;
            const char* a3 = a2 + kstep; const char* b3 = b2 + kstep;
            if (last && has_next) S.a_ready(nxt);
            if constexpr (SP2) {
            PG8_LDB(B0, 0, 0); PG8_LDB(B1, 0, 1); PG8_SCHED; PG8_LDA(At, 0, 0); PG8_STAGE(PG8_SA(1, 1), a1 + hstep, voffA);
            PG8_WAIT_V(8); PG8_WAIT_L(0); PG8_BAR; PG8_MMA(0, 0, At, B0); PG8_MMA(0, 1, At, B1); PG8_BAR; PG8_SCHED;
            PG8_LDA(At, 0, 1); PG8_STAGE(PG8_SB(0, 0), b2, voffB); PG8_STAGE(PG8_SB(0, 1), b2 + hstep, voffB); PG8_STAGE(PG8_SA(0, 0), a2, voffA);
            PG8_WAIT_V(8); PG8_WAIT_L(0); PG8_BAR; PG8_MMA(1, 0, At, B0); PG8_MMA(1, 1, At, B1); PG8_BAR; PG8_SCHED;
            PG8_LDB(B0, 1, 0); PG8_LDB(B1, 1, 1); PG8_SCHED; PG8_LDA(At, 1, 0); PG8_STAGE(PG8_SA(0, 1), a2 + hstep, voffA);
            PG8_WAIT_V(8); PG8_WAIT_L(0); PG8_BAR; PG8_MMA(0, 0, At, B0); PG8_MMA(0, 1, At, B1); PG8_BAR; PG8_SCHED;
            PG8_LDA(At, 1, 1); PG8_STAGE(PG8_SB(1, 0), b3, voffB); PG8_STAGE(PG8_SB(1, 1), b3 + hstep, voffB); PG8_STAGE(PG8_SA(1, 0), a3, voffA);
            PG8_WAIT_V(8); PG8_WAIT_L(0); PG8_BAR; PG8_MMA(1, 0, At, B0); PG8_MMA(1, 1, At, B1); PG8_BAR; PG8_SCHED;
            } else {
            PG8_LDB(B0, 0, 0); PG8_SCHED; PG8_LDA(At, 0, 0); PG8_STAGE(PG8_SA(1, 1), a1 + hstep, voffA);
            PG8_WAIT_L(8); PG8_BAR; PG8_WAIT_L(0); PG8_MMA(0, 0, At, B0); PG8_BAR; PG8_SCHED;
            PG8_LDB(B1, 0, 1); PG8_STAGE(PG8_SB(0, 0), b2, voffB);
            PG8_BAR; PG8_WAIT_L(0); PG8_MMA(0, 1, At, B1); PG8_BAR;
            PG8_LDA(At, 0, 1); PG8_STAGE(PG8_SA(0, 0), a2, voffA);
            PG8_BAR; PG8_WAIT_L(0); PG8_MMA(1, 0, At, B0); PG8_BAR; PG8_SCHED;
            PG8_STAGE(PG8_SB(0, 1), b2 + hstep, voffB);
            PG8_WAIT_V(6); PG8_BAR; PG8_MMA(1, 1, At, B1); PG8_BAR;
            PG8_LDB(B0, 1, 0); PG8_SCHED; PG8_LDA(At, 1, 0); PG8_STAGE(PG8_SA(0, 1), a2 + hstep, voffA);
            PG8_WAIT_L(8); PG8_BAR; PG8_WAIT_L(0); PG8_MMA(0, 0, At, B0); PG8_BAR; PG8_SCHED;
            PG8_LDB(B1, 1, 1); PG8_STAGE(PG8_SB(1, 0), b3, voffB);
            PG8_BAR; PG8_WAIT_L(0); PG8_MMA(0, 1, At, B1); PG8_BAR;
            PG8_LDA(At, 1, 1); PG8_STAGE(PG8_SA(1, 0), a3, voffA);
            PG8_BAR; PG8_WAIT_L(0); PG8_MMA(1, 0, At, B0); PG8_BAR; PG8_SCHED;
            PG8_STAGE(PG8_SB(1, 1), b3 + hstep, voffB);
            PG8_WAIT_V(6); PG8_BAR; PG8_MMA(1, 1, At, B1); PG8_BAR;
            }
        }
        if constexpr (ALIGN_EPI) { if (wr == 0) PG8_BAR; }
        if constexpr (!Epi::AFTER_DRAIN) { E(acc, cur, wr, wc, fr, fq); S.done(cur); }
        if (!has_next) break;
        if (nxt.sub == 0) {
#pragma unroll
        for (int a = 0; a < 2; ++a)
#pragma unroll
            for (int b = 0; b < 2; ++b)
#pragma unroll
                for (int m = 0; m < 4; ++m)
#pragma unroll
                    for (int n = 0; n < 2; ++n) acc[a][b][m][n] = (f32x4){0.f, 0.f, 0.f, 0.f};
        }
        cur = nxt; cA = nA; cB = nB; ++ui;
        if constexpr (ALIGN_EPI) { if (wr == 1) PG8_BAR; }
    }
    PG8_WAIT_V(0);
    if constexpr (!ALIGN_EPI) { if (wr == 0) PG8_BAR; }
    PG8_BAR;
    if constexpr (Epi::AFTER_DRAIN) { E.fused(acc, cur, wr, wc, fr, fq, lds, wid, lane); S.done(cur); }
#undef PG8_SA
#undef PG8_SB
#undef PG8_STAGE
#undef PG8_LDA
#undef PG8_LDB
#undef PG8_MMA
#undef PG8_WAIT_V
#undef PG8_WAIT_L
#undef PG8_BAR
#undef PG8_SCHED
}
}

#define GAS __attribute__((address_space(1)))
#define LAS __attribute__((address_space(3)))
typedef unsigned short bf16;
typedef unsigned v4u __attribute__((ext_vector_type(4)));
typedef unsigned v2u __attribute__((ext_vector_type(2)));
typedef float f32x4 __attribute__((ext_vector_type(4)));
typedef GAS unsigned gu32;
#define RLX_AGENT __ATOMIC_RELAXED, __HIP_MEMORY_SCOPE_AGENT
#define LDS_WAIT() asm volatile("s_waitcnt lgkmcnt(0)" ::: "memory")
#define VM_WAIT() asm volatile("s_waitcnt vmcnt(0)" ::: "memory")
__device__ __forceinline__ unsigned f2bf(float f) { unsigned u = __builtin_bit_cast(unsigned, f); return (u + 0x7fffu + ((u >> 16) & 1u)) >> 16; }
__device__ __forceinline__ unsigned pk2(float lo, float hi) { return f2bf(lo) | (f2bf(hi) << 16); }
__device__ __forceinline__ float bf2f(unsigned v) { return __builtin_bit_cast(float, v << 16); }
__device__ __forceinline__ float bflo(unsigned w) { return __builtin_bit_cast(float, w << 16); }
__device__ __forceinline__ float bfhi(unsigned w) { return __builtin_bit_cast(float, w & 0xffff0000u); }
__device__ __forceinline__ float sigmoidf_(float x) { return 1.f / (1.f + __expf(-x)); }
__device__ __forceinline__ float siluf_(float x) { return x / (1.f + __expf(-x)); }
__device__ __forceinline__ float logsigmoidf_(float x) { return fminf(x, 0.f) - log1pf(expf(-fabsf(x))); }
__device__ __forceinline__ float wave_sum(float v) {
#pragma unroll
    for (int o = 1; o < 64; o <<= 1) v += __shfl_xor(v, o);
    return v;
}

constexpr size_t MiB = 1u << 20;
constexpr size_t WS_CTL = 0, CTL_ZERO_BYTES = 1 * MiB;
constexpr size_t WS_GATES = 1 * MiB;
constexpr size_t WS_R1 = 1 * MiB + 640 * 1024;
constexpr size_t WS_ROPE = 2 * MiB;
constexpr size_t WS_WA = 3 * MiB, WS_WB = 7 * MiB, WS_WOUT = 11 * MiB, WS_WDOWN = 19 * MiB;
constexpr size_t WS_W1 = 41 * MiB;
constexpr size_t WS_A = 85 * MiB;
constexpr size_t WS_X = 118 * MiB;
constexpr size_t WS_P = 170 * MiB;
constexpr size_t WS_ACT = 41 * MiB;
constexpr size_t WS_END = 352 * MiB;
static_assert(WS_P + (size_t)MP * PW * 2 <= WS_END && WS_ACT + (size_t)NX * FFN * 2 <= WS_P && WS_X + (size_t)MP * 2048 * 2 <= WS_P, "d_ws map");
static_assert(WS_WDOWN + (size_t)2048 * FFN * 2 <= WS_W1 && WS_W1 + (size_t)PW * 2048 * 2 <= WS_A && WS_A + (size_t)MP * 2048 * 2 <= WS_X, "d_ws map 2");
constexpr int CW_BAR = 4096;
constexpr int CW_SS2 = 16384, CW_SS3 = 32768;
constexpr int CW_WQ = 49152;

constexpr int RING_OFF = 0, RING_BYTES = 131072;
constexpr int LDSCTL_OFF = RING_BYTES, MISC_OFF = LDSCTL_OFF + 320;
constexpr int LDS_BYTES = 147456;
constexpr int NWAVES = 8;

#define XB_TMO      128
#define XB_XCNT(j)  (256  + 64 * (j))
#define XB_XSUB(j)  (1280 + 64 * (j))
#define XB_XGEN(j)  (2304 + 64 * (j))
#define XB_TOP      3328
#define XB_TOPGEN   3392
#define XCD_BAR_WORDS 3456
#define XB_SPIN_CAP (1u << 18)

__device__ __forceinline__ unsigned xb_ld(unsigned* p)              { return __hip_atomic_load(p, __ATOMIC_RELAXED, __HIP_MEMORY_SCOPE_AGENT); }
__device__ __forceinline__ unsigned xb_add(unsigned* p, unsigned v) { return __hip_atomic_fetch_add(p, v, __ATOMIC_RELAXED, __HIP_MEMORY_SCOPE_AGENT); }
__device__ __forceinline__ unsigned xb_xcc_id() { return (unsigned)__builtin_amdgcn_s_getreg((3 << 11) | 20) & 0xFu; }
#define XB_SPIN(cond, bar) do { unsigned _sp = 0; while (cond) { __builtin_amdgcn_s_sleep(1); \
    if ((++_sp & 255u) == 0u) { if (xb_ld(&(bar)[XB_TMO])) break; if (_sp > XB_SPIN_CAP) { atomicAdd(&(bar)[XB_TMO], 1u); break; } } } } while (0)

struct XcdBarrier {
    unsigned* bar; unsigned x;
    volatile LAS unsigned* st;
};

__device__ __forceinline__ XcdBarrier xcd_barrier_post(unsigned* bar, volatile LAS unsigned* st) {
    XcdBarrier b; b.bar = bar; b.x = xb_xcc_id(); b.st = st;
    if (threadIdx.x == 0) (void)xb_add(&bar[XB_XCNT(b.x)], 1u);
    return b;
}
__device__ __forceinline__ void xcd_barrier_complete(unsigned* bar, unsigned x, unsigned& nloc, unsigned& nx) {
    const unsigned G = gridDim.x * gridDim.y * gridDim.z;
    unsigned sum, cnt, mine, sp = 0u;
    for (;;) {
        sum = 0u; cnt = 0u; mine = 0u;
#pragma unroll
        for (unsigned j = 0; j < 16; ++j) { const unsigned c = xb_ld(&bar[XB_XCNT(j)]); sum += c; cnt += (c > 0u) ? 1u : 0u; mine = (j == x) ? c : mine; }
        if (sum == G) break;
        __builtin_amdgcn_s_sleep(1);
        if ((++sp & 255u) == 0u) { if (xb_ld(&bar[XB_TMO])) break; if (sp > XB_SPIN_CAP) { atomicAdd(&bar[XB_TMO], 1u); break; } }
    }
    nloc = mine > 0u ? mine : 1u; nx = cnt > 0u ? cnt : 1u;
}

__device__ __forceinline__ void xcd_barrier(const XcdBarrier& b) {
    asm volatile("s_waitcnt vmcnt(0)" ::: "memory");
    __syncthreads();
    if (threadIdx.x == 0) {
        unsigned* bar = b.bar;
        __builtin_amdgcn_s_waitcnt(0);
        unsigned nloc = b.st[0], nx = b.st[1];
        if (nloc == 0u) { xcd_barrier_complete(bar, b.x, nloc, nx); b.st[0] = nloc; b.st[1] = nx; }
        const unsigned old = xb_add(&bar[XB_XSUB(b.x)], 1u);
        const unsigned gen = old / nloc;
        if (old + 1u == (gen + 1u) * nloc) {
            __builtin_amdgcn_fence(__ATOMIC_RELEASE, "agent");
            asm volatile("s_waitcnt vmcnt(0)" ::: "memory");
            const unsigned og = xb_add(&bar[XB_TOP], 1u);
            const unsigned tg = og / nx;
            if (og + 1u == (tg + 1u) * nx) xb_add(&bar[XB_TOPGEN], 1u);
            else XB_SPIN(xb_ld(&bar[XB_TOPGEN]) == tg, bar);
            __builtin_amdgcn_fence(__ATOMIC_ACQUIRE, "agent");
            xb_add(&bar[XB_XGEN(b.x)], 1u);
            asm volatile("s_waitcnt vmcnt(0)" ::: "memory");
        } else {
            XB_SPIN(xb_ld(&bar[XB_XGEN(b.x)]) == gen, bar);
            __builtin_amdgcn_fence(__ATOMIC_ACQUIRE, "agent");
            asm volatile("s_waitcnt vmcnt(0)" ::: "memory");
        }
    }
    __syncthreads();
}

namespace pg8 {
struct EpiProj {
    static constexpr bool PERM = true, AFTER_DRAIN = false;
    bf16_t* O; const float* r1; const float* rope;
    __device__ __forceinline__ void operator()(f32x4 (&acc)[2][2][4][2], const Unit& u, int wr, int wc, int fr, int fq) const {
        const int row0 = u.pm * BM + wr * 64 + fr, col0 = u.pn * BM + wc * 32 + 8 * fq;
        const bool ropet = (u.pn >= P_DQ / 256) && (u.pn < P_DV / 256) && ((wc & 1) == 0);
#pragma unroll
        for (int ai = 0; ai < 2; ++ai)
#pragma unroll
            for (int m = 0; m < 4; ++m) {
                const int row = row0 + ai * HALF + m * 16; const float rs = r1[row];
                f32x4 cs[4];
                if (ropet) { int b, p; row2bp(row < NR ? row : 0, b, p); const f32x4* rp = (const f32x4*)(rope + (size_t)p * 16);
#pragma unroll
                    for (int q = 0; q < 4; ++q) cs[q] = rp[q]; }
                bf16_t* rowp = O + (size_t)row * PW + col0;
#pragma unroll
                for (int bj = 0; bj < 2; ++bj) {
                    f32x4 v0 = acc[ai][bj][m][0] * rs, v1 = acc[ai][bj][m][1] * rs;
                    if (ropet) {
                        f32x4 o0, o1;
#pragma unroll
                        for (int e = 0; e < 4; ++e) { o0[e] = __shfl_xor(v0[e], 16); o1[e] = __shfl_xor(v1[e], 16); }
                        const float sg = (fq == 0) ? -1.f : 1.f;
                        if (fq < 2) {
                            v0 = (f32x4){v0[0] * cs[0][0] + sg * o0[0] * cs[0][1], v0[1] * cs[0][2] + sg * o0[1] * cs[0][3], v0[2] * cs[1][0] + sg * o0[2] * cs[1][1], v0[3] * cs[1][2] + sg * o0[3] * cs[1][3]};
                            v1 = (f32x4){v1[0] * cs[2][0] + sg * o1[0] * cs[2][1], v1[1] * cs[2][2] + sg * o1[1] * cs[2][3], v1[2] * cs[3][0] + sg * o1[2] * cs[3][1], v1[3] * cs[3][2] + sg * o1[3] * cs[3][3]};
                        }
                    }
                    u32x4 w; w.x = cvt_pk_bf16(v0[0], v0[1]); w.y = cvt_pk_bf16(v0[2], v0[3]); w.z = cvt_pk_bf16(v1[0], v1[1]); w.w = cvt_pk_bf16(v1[2], v1[3]);
                    *(u32x4*)(rowp + bj * HALF) = w;
                }
            }
    }
};
struct EpiMerged {
    static constexpr bool PERM = true, AFTER_DRAIN = false;
    const bf16_t* P; bf16_t* O;
    __device__ __forceinline__ void operator()(f32x4 (&acc)[2][2][4][2], const Unit& u, int wr, int wc, int fr, int fq) const {
        const int row0 = u.pm * BM + wr * 64 + fr, col0 = u.pn * BM + wc * 32 + 8 * fq;
#pragma unroll
        for (int ai = 0; ai < 2; ++ai)
#pragma unroll
            for (int m = 0; m < 4; ++m) {
                const int row = row0 + ai * HALF + m * 16;
#pragma unroll
                for (int bj = 0; bj < 2; ++bj) {
                    const int col = col0 + bj * HALF;
                    const u32x4 gd = *(const u32x4*)(P + (size_t)row * PW + P_GD + col);
                    float ed[8];
#pragma unroll
                    for (int q = 0; q < 4; ++q) { ed[2 * q] = __expf(-bflo(gd[q])); ed[2 * q + 1] = __expf(-bfhi(gd[q])); }
                    if (u.sub == 0) {
                        const u32x4 gm = *(const u32x4*)(P + (size_t)row * PW + P_GM + col);
#pragma unroll
                        for (int q = 0; q < 4; ++q) { const float em0 = __expf(-bflo(gm[q])), em1 = __expf(-bfhi(gm[q]));
                            const float r0 = (1.f + ed[2 * q]) / (1.f + em0), r1_ = (1.f + ed[2 * q + 1]) / (1.f + em1);
                            if (q < 2) { acc[ai][bj][m][0][2 * q] *= r0; acc[ai][bj][m][0][2 * q + 1] *= r1_; } else { acc[ai][bj][m][1][2 * q - 4] *= r0; acc[ai][bj][m][1][2 * q - 3] *= r1_; } }
                    } else {
                        float o[8];
#pragma unroll
                        for (int e = 0; e < 4; ++e) { o[e] = acc[ai][bj][m][0][e] / (1.f + ed[e]); o[4 + e] = acc[ai][bj][m][1][e] / (1.f + ed[4 + e]); }
                        u32x4 w; w.x = cvt_pk_bf16(o[0], o[1]); w.y = cvt_pk_bf16(o[2], o[3]); w.z = cvt_pk_bf16(o[4], o[5]); w.w = cvt_pk_bf16(o[6], o[7]);
                        *(u32x4*)(O + (size_t)row * 2048 + col) = w;
                    }
                }
            }
    }
};
struct EpiOut {
    static constexpr bool PERM = true, AFTER_DRAIN = false;
    const float* x; const float* meta; const float* g2; float* out; bf16_t* A2; float* ss;
    __device__ __forceinline__ void operator()(f32x4 (&acc)[2][2][4][2], const Unit& u, int wr, int wc, int fr, int fq) const {
        const int row0 = u.pm * BM + wr * 64 + fr, col0 = u.pn * BM + wc * 32 + 8 * fq;
        f32x4 gv[2][2];
#pragma unroll
        for (int bj = 0; bj < 2; ++bj) { gv[bj][0] = *(const f32x4*)(g2 + col0 + bj * HALF); gv[bj][1] = *(const f32x4*)(g2 + col0 + bj * HALF + 4); }
#pragma unroll
        for (int ai = 0; ai < 2; ++ai)
#pragma unroll
            for (int m = 0; m < 4; ++m) {
                const int row = row0 + ai * HALF + m * 16;
                const float* hr = row < NX ? x + (size_t)row * D : meta + (size_t)((row - NX) & 15) * D;
                float s = 0.f;
#pragma unroll
                for (int bj = 0; bj < 2; ++bj) {
                    const int col = col0 + bj * HALF;
                    const f32x4 h0 = *(const f32x4*)(hr + col) + acc[ai][bj][m][0], h1 = *(const f32x4*)(hr + col + 4) + acc[ai][bj][m][1];
                    s += (h0[0] * h0[0] + h0[1] * h0[1]) + (h0[2] * h0[2] + h0[3] * h0[3]) + (h1[0] * h1[0] + h1[1] * h1[1]) + (h1[2] * h1[2] + h1[3] * h1[3]);
                    if (row < NX) { *(f32x4*)(out + (size_t)row * D + col) = h0; *(f32x4*)(out + (size_t)row * D + col + 4) = h1; }
                    const f32x4 a0 = h0 * gv[bj][0], a1 = h1 * gv[bj][1];
                    u32x4 w; w.x = cvt_pk_bf16(a0[0], a0[1]); w.y = cvt_pk_bf16(a0[2], a0[3]); w.z = cvt_pk_bf16(a1[0], a1[1]); w.w = cvt_pk_bf16(a1[2], a1[3]);
                    *(u32x4*)(A2 + (size_t)row * D + col) = w;
                }
                s += __shfl_xor(s, 16); s += __shfl_xor(s, 32);
                if (fq == 0) atomicAdd(ss + row, s);
            }
    }
};
struct EpiUp {
    static constexpr bool PERM = true, AFTER_DRAIN = false;
    bf16_t* O; const float* ss;
    __device__ __forceinline__ void operator()(f32x4 (&acc)[2][2][4][2], const Unit& u, int wr, int wc, int fr, int fq) const {
        const int row0 = u.pm * BM + wr * 64 + fr, col0 = u.pn * BM + wc * 32 + 8 * fq;
#pragma unroll
        for (int ai = 0; ai < 2; ++ai)
#pragma unroll
            for (int m = 0; m < 4; ++m) {
                const int row = row0 + ai * HALF + m * 16; const float rs = rsqrtf(ss[row] * (1.f / D) + EPS);
                bf16_t* rowp = O + (size_t)row * PW + col0;
#pragma unroll
                for (int bj = 0; bj < 2; ++bj) { const f32x4 v0 = acc[ai][bj][m][0] * rs, v1 = acc[ai][bj][m][1] * rs;
                    u32x4 w; w.x = cvt_pk_bf16(v0[0], v0[1]); w.y = cvt_pk_bf16(v0[2], v0[3]); w.z = cvt_pk_bf16(v1[0], v1[1]); w.w = cvt_pk_bf16(v1[2], v1[3]);
                    *(u32x4*)(rowp + bj * HALF) = w; }
            }
    }
};
struct EpiDown {
    static constexpr bool PERM = true, AFTER_DRAIN = false;
    float* out; float* ss;
    __device__ __forceinline__ void operator()(f32x4 (&acc)[2][2][4][2], const Unit& u, int wr, int wc, int fr, int fq) const {
        const int row0 = u.pm * BM + wr * 64 + fr, col0 = u.pn * BM + wc * 32 + 8 * fq;
#pragma unroll
        for (int ai = 0; ai < 2; ++ai)
#pragma unroll
            for (int m = 0; m < 4; ++m) {
                const int row = row0 + ai * HALF + m * 16; float s = 0.f;
#pragma unroll
                for (int bj = 0; bj < 2; ++bj) {
                    float* p = out + (size_t)row * D + col0 + bj * HALF;
                    const f32x4 h0 = *(const f32x4*)p + acc[ai][bj][m][0], h1 = *(const f32x4*)(p + 4) + acc[ai][bj][m][1];
                    s += (h0[0] * h0[0] + h0[1] * h0[1]) + (h0[2] * h0[2] + h0[3] * h0[3]) + (h1[0] * h1[0] + h1[1] * h1[1]) + (h1[2] * h1[2] + h1[3] * h1[3]);
                    *(f32x4*)p = h0; *(f32x4*)(p + 4) = h1;
                }
                s += __shfl_xor(s, 16); s += __shfl_xor(s, 32);
                if (fq == 0) atomicAdd(ss + row, s);
            }
    }
};
struct PairOrder {
    StaticOrder S;
    __device__ bool next(int i, Unit& u) const { const bool ok = S.next(i >> 1, u); u.sub = i & 1; return ok; }
    __device__ __forceinline__ void a_ready(const Unit&) const {}
    __device__ __forceinline__ void done(const Unit&) const {}
};
}

__device__ __forceinline__ void transpose_item(const float* W, int ldw, int K, int ncols, bf16* WT, int row_off, LAS float* scr, int item, int lane) {
    const int nblk = ncols / 32, kb = item / nblk, nb = item % nblk, k0 = 64 * kb, n0 = 32 * nb;
#pragma unroll 8
    for (int i = 0; i < 32; ++i) { const int kk = 2 * i + (lane >> 5); scr[kk * 33 + (lane & 31)] = W[(size_t)(k0 + kk) * ldw + n0 + (lane & 31)]; }
    LDS_WAIT(); asm volatile("" ::: "memory");
    const int c = lane & 7;
#pragma unroll
    for (int j = 0; j < 4; ++j) { const int n = (lane >> 3) + 8 * j; const LAS float* s = scr + (8 * c) * 33 + n;
        v4u o; o.x = pk2(s[0 * 33], s[1 * 33]); o.y = pk2(s[2 * 33], s[3 * 33]); o.z = pk2(s[4 * 33], s[5 * 33]); o.w = pk2(s[6 * 33], s[7 * 33]);
        *(GAS v4u*)(WT + (size_t)(row_off + n0 + n) * K + k0 + 8 * c) = o; }
    LDS_WAIT(); asm volatile("" ::: "memory");
}

struct Args { const float* in[20]; float* out; unsigned char* ws; int ph_lo, ph_hi; };
enum { I_X = 0, I_META, I_G1, I_WIN, I_MCONV, I_GBIAS, I_MNG, I_LQ1, I_LK1, I_LQ2, I_LK2, I_SG, I_WA, I_WB, I_WOUT, I_G2, I_WUP, I_FCONV, I_WDOWN, I_GF };
constexpr int N_PHASES = 8;
#ifndef MK_ONE_LAUNCH
#define MK_ONE_LAUNCH 0
#endif

__global__ void __launch_bounds__(NWAVES * 64, 2) mk_fwd(Args args) {
    extern __shared__ __attribute__((aligned(16))) unsigned char lds_raw[];
    LAS unsigned char* lds = (LAS unsigned char*)lds_raw;
    volatile LAS unsigned* MISC = (volatile LAS unsigned*)(lds + MISC_OFF);
    const int tid = threadIdx.x, lane = tid & 63, wave = __builtin_amdgcn_readfirstlane(tid >> 6);
    const int G = gridDim.x; const int bx = blockIdx.x; const int vcu = (G % 8 == 0) ? (bx % 8) * (G / 8) + bx / 8 : bx;
    unsigned char* ws = args.ws;
    gu32* ctl = (gu32*)(ws + WS_CTL);
    for (int u = tid; u < (LDS_BYTES - LDSCTL_OFF) / 4; u += NWAVES * 64) ((LAS unsigned*)(lds + LDSCTL_OFF))[u] = 0u;
    __syncthreads();
    XcdBarrier bar; bar.bar = (unsigned*)(ctl + CW_BAR); bar.x = 0; bar.st = nullptr;
    if (MK_ONE_LAUNCH) bar = xcd_barrier_post((unsigned*)(ctl + CW_BAR), MISC + 8);
    const int lo = args.ph_lo, hi = args.ph_hi;
#define IN(k) (lo <= (k) && (k) < hi)
#define SEAM(k) do { if (IN(k) && IN((k) + 1)) xcd_barrier(bar); } while (0)
    const float* x = args.in[I_X]; const float* meta = args.in[I_META];
    bf16* WT_IN = (bf16*)(ws + WS_W1); bf16* WT_UP = (bf16*)(ws + WS_W1); bf16* WT_A = (bf16*)(ws + WS_WA); bf16* WT_B = (bf16*)(ws + WS_WB); bf16* WT_OUT = (bf16*)(ws + WS_WOUT); bf16* WT_DOWN = (bf16*)(ws + WS_WDOWN);
    bf16* A1 = (bf16*)(ws + WS_A); bf16* AOUT = (bf16*)(ws + WS_A); bf16* BOUT = AOUT + (size_t)MP * 1024; bf16* A2 = (bf16*)(ws + WS_A);
    bf16* MERGED = (bf16*)(ws + WS_X); bf16* PROJ = (bf16*)(ws + WS_P); bf16* UP = (bf16*)(ws + WS_P); bf16* ACT = (bf16*)(ws + WS_ACT);
    float* GATES = (float*)(ws + WS_GATES); float* R1 = (float*)(ws + WS_R1); float* ROPE = (float*)(ws + WS_ROPE);
    float* SS2 = (float*)(ws + WS_CTL) + CW_SS2; float* SS3 = (float*)(ws + WS_CTL) + CW_SS3;
    const int gw = vcu * NWAVES + wave, NGW = G * NWAVES;
    LAS float* scr = (LAS float*)(lds + RING_OFF + wave * 16384);

    if (IN(0)) {
        const float* w_in = args.in[I_WIN];
        constexpr int I0 = 32 * (4096 / 32), I1 = 32 * (7168 / 32), IA = 16 * 64, IO = 32 * 64, ID = 88 * 64;
        constexpr int NITEMS = I0 + I1 + 2 * IA + IO + ID;
        for (int it = gw; it < NITEMS; it += NGW) {
            int r = it;
            if (r < I0) { transpose_item(w_in, INW, D, 4096, WT_IN, 0, scr, r, lane); continue; } r -= I0;
            if (r < I1) { transpose_item(w_in + 4112, INW, D, 7168, WT_IN, 4096, scr, r, lane); continue; } r -= I1;
            if (r < IA) { transpose_item(args.in[I_WA], D, 1024, 2048, WT_A, 0, scr, r, lane); continue; } r -= IA;
            if (r < IA) { transpose_item(args.in[I_WB], D, 1024, 2048, WT_B, 0, scr, r, lane); continue; } r -= IA;
            if (r < IO) { transpose_item(args.in[I_WOUT], D, D, 2048, WT_OUT, 0, scr, r, lane); continue; } r -= IO;
            transpose_item(args.in[I_WDOWN], D, FFN, 2048, WT_DOWN, 0, scr, r, lane);
        }
        const float* g1 = args.in[I_G1];
        for (int row = gw; row < MP; row += NGW) {
            GAS v2u* ao = (GAS v2u*)(A1 + (size_t)row * D) + lane;
            if (row >= NR) { for (int j = 0; j < 8; ++j) ao[64 * j] = (v2u){0u, 0u}; if (lane == 0) R1[row] = 0.f; continue; }
            const float* hr = row < NX ? x + (size_t)row * D : meta + (size_t)((row - NX) & 15) * D;
            f32x4 v[8]; float s = 0.f;
#pragma unroll
            for (int j = 0; j < 8; ++j) { v[j] = *(const f32x4*)(hr + 4 * lane + 256 * j); s += (v[j][0] * v[j][0] + v[j][1] * v[j][1]) + (v[j][2] * v[j][2] + v[j][3] * v[j][3]); }
            const float r = rsqrtf(wave_sum(s) * (1.f / D) + EPS);
            float ga[16];
#pragma unroll
            for (int q = 0; q < 16; ++q) ga[q] = 0.f;
#pragma unroll
            for (int j = 0; j < 8; ++j) {
                const f32x4 a = v[j] * *(const f32x4*)(g1 + 4 * lane + 256 * j);
                ao[64 * j] = (v2u){pk2(a[0], a[1]), pk2(a[2], a[3])};
#pragma unroll
                for (int e = 0; e < 4; ++e) { const f32x4* wg = (const f32x4*)(w_in + (size_t)(4 * lane + 256 * j + e) * INW + C_G);
#pragma unroll
                    for (int q = 0; q < 4; ++q) { const f32x4 wv = wg[q]; ga[4 * q] += a[e] * wv[0]; ga[4 * q + 1] += a[e] * wv[1]; ga[4 * q + 2] += a[e] * wv[2]; ga[4 * q + 3] += a[e] * wv[3]; } }
            }
#pragma unroll
            for (int q = 0; q < 16; ++q) ga[q] = wave_sum(ga[q]);
            if (lane == 0) { R1[row] = r;
#pragma unroll
                for (int q = 0; q < 16; ++q) GATES[(size_t)row * 16 + q] = ga[q] * r; }
        }
        for (int i = (vcu * NWAVES * 64) + tid; i < L * 8; i += G * NWAVES * 64) { const int p = i >> 3, j = i & 7;
            const float ang = (float)p * powf(500000.f, -(float)j / 8.f); ROPE[(size_t)p * 16 + 2 * j] = cosf(ang); ROPE[(size_t)p * 16 + 2 * j + 1] = sinf(ang); }
    }
    SEAM(0);
    if (IN(1)) {
        pg8::Gemm g{A1, WT_IN, MP, PW, D, A1, WT_IN}; pg8::StaticOrder S; S.init(MP, PW, G, bx);
        pg8::EpiProj E{PROJ, R1, ROPE};
        pg8::gemm_phase<pg8::EpiProj, pg8::StaticOrder, true, true>(lds + RING_OFF, g, S, E);
    }
    SEAM(1);
    if (IN(2)) {
        constexpr int IU = 32 * (PW / 32);
        for (int it = gw; it < IU; it += NGW) transpose_item(args.in[I_WUP], PW, D, PW, WT_UP, 0, scr, it, lane);
    }
    SEAM(2);
    if (IN(3)) {
        pg8::Gemm g{AOUT, WT_A, MP, D, 1024, BOUT, WT_B}; pg8::PairOrder S; S.S.init(MP, D, G, bx);
        pg8::EpiMerged E{PROJ, MERGED};
        pg8::gemm_phase<pg8::EpiMerged, pg8::PairOrder, false, true>(lds + RING_OFF, g, S, E);
    }
    SEAM(3);
    if (IN(4)) {
        pg8::Gemm g{MERGED, WT_OUT, MP, D, D, MERGED, WT_OUT}; pg8::StaticOrder S; S.init(MP, D, G, bx);
        pg8::EpiOut E{x, meta, args.in[I_G2], args.out, A2, SS2};
        pg8::gemm_phase<pg8::EpiOut, pg8::StaticOrder, true, true>(lds + RING_OFF, g, S, E);
    }
    SEAM(4);
    if (IN(5)) {
        pg8::Gemm g{A2, WT_UP, MP, PW, D, A2, WT_UP}; pg8::StaticOrder S; S.init(MP, PW, G, bx);
        pg8::EpiUp E{UP, SS2};
        pg8::gemm_phase<pg8::EpiUp, pg8::StaticOrder, true, true>(lds + RING_OFF, g, S, E);
    }
    SEAM(5);
    if (IN(6)) {
        pg8::Gemm g{ACT, WT_DOWN, NX, D, FFN, ACT, WT_DOWN}; pg8::StaticOrder S; S.init(NX, D, G, bx);
        pg8::EpiDown E{args.out, SS3};
        pg8::gemm_phase<pg8::EpiDown, pg8::StaticOrder, true, true>(lds + RING_OFF, g, S, E);
    }
    SEAM(6);
    if (IN(7)) {
        const float* gf = args.in[I_GF];
        for (int row = gw; row < NX; row += NGW) {
            const float rs = rsqrtf(__hip_atomic_load(SS3 + row, RLX_AGENT) * (1.f / D) + EPS);
            float* o = args.out + (size_t)row * D;
#pragma unroll
            for (int j = 0; j < 8; ++j) { const int c = 4 * lane + 256 * j; f32x4 v = *(const f32x4*)(o + c); v = (v * rs) * *(const f32x4*)(gf + c); *(f32x4*)(o + c) = v; }
        }
    }
#undef IN
#undef SEAM
}

__global__ void __launch_bounds__(1024) s_mlstm(const bf16* PROJ, const float* gates, const float* gbias, const float* cw, bf16* hf, bf16* hb) {
    __shared__ float q[256], k[256], v[256], n[256], red[16];
    const int dir = blockIdx.x & 1, head = (blockIdx.x >> 1) & 3, b = blockIdx.x >> 3;
    const int tid = threadIdx.x, vv = tid >> 2, dq = tid & 3;
    float C[64];
#pragma unroll
    for (int i = 0; i < 64; ++i) C[i] = 0.f;
    if (tid < 256) n[tid] = 0.f;
    float m = 0.f;
    bf16* out = dir ? hb : hf;
    const int ccol = tid < 256 ? head * 256 + tid : 1024 + head * 256 + (tid - 256);
    float w0 = 0.f, w1 = 0.f, w2 = 0.f; if (tid < 512) { w0 = cw[ccol]; w1 = cw[2048 + ccol]; w2 = cw[4096 + ccol]; }
    __syncthreads();
    for (int step = 0; step < L; ++step) {
        const int p = dir ? (L - 1 - step) : step; const int row = rowof(b, p);
        if (tid < 512) {
            const float xm = p > 0 ? bf2f(PROJ[(size_t)rowof(b, p - 1) * PW + P_MQK + ccol]) : 0.f, x0 = bf2f(PROJ[(size_t)row * PW + P_MQK + ccol]), xp = p < L - 1 ? bf2f(PROJ[(size_t)rowof(b, p + 1) * PW + P_MQK + ccol]) : 0.f;
            const float y = siluf_(xm * w0 + x0 * w1 + xp * w2);
            if (tid < 256) q[tid] = y; else k[tid - 256] = y * 0.0625f;
        } else if (tid < 768) v[tid - 512] = bf2f(PROJ[(size_t)row * PW + P_MV + head * 256 + tid - 512]);
        const float li = gates[(size_t)row * 16 + dir * 8 + head] + gbias[dir * 8 + head];
        const float lf = logsigmoidf_(gates[(size_t)row * 16 + dir * 8 + 4 + head] + gbias[dir * 8 + 4 + head]);
        const float mn = fmaxf(lf + m, li), fd = expf(lf + m - mn), iw = expf(li - mn);
        m = mn;
        __syncthreads();
        const float vi = v[vv] * iw; float part = 0.f;
#pragma unroll
        for (int i = 0; i < 64; ++i) { const int d = dq * 64 + i; C[i] = fd * C[i] + vi * k[d]; part += C[i] * q[d]; }
        part += __shfl_xor(part, 1); part += __shfl_xor(part, 2);
        float dpart = 0.f;
        if (tid < 256) { const float nn = fd * n[tid] + iw * k[tid]; n[tid] = nn; dpart = nn * q[tid]; }
        for (int o = 32; o > 0; o >>= 1) dpart += __shfl_xor(dpart, o);
        if ((tid & 63) == 0) red[tid >> 6] = dpart;
        __syncthreads();
        const float den = red[0] + red[1] + red[2] + red[3];
        if (dq == 0) out[(size_t)row * 1024 + head * 256 + vv] = (bf16)f2bf(part / fmaxf(fabsf(den), expf(-mn)));
        __syncthreads();
    }
}
__device__ __forceinline__ float block_sum256(float v, float* red) {
    for (int o = 32; o > 0; o >>= 1) v += __shfl_xor(v, o);
    __syncthreads();
    if ((threadIdx.x & 63) == 0) red[threadIdx.x >> 6] = v;
    __syncthreads();
    return red[0] + red[1] + red[2] + red[3];
}
__global__ void __launch_bounds__(256) s_mlstm_out(const bf16* hf, const bf16* hb, const bf16* PROJ, const float* ng, bf16* aout) {
    __shared__ float red[8];
    for (int row = blockIdx.x; row < NR; row += gridDim.x)
        for (int head = 0; head < MH; ++head) {
            const size_t o = (size_t)row * 1024 + head * 256 + threadIdx.x;
            const float hs = bf2f(hf[o]) + bf2f(hb[o]);
            const float mu = block_sum256(hs, red) / 256.f; const float dv = hs - mu;
            const float var = block_sum256(dv * dv, red) / 256.f;
            const float mo = bf2f(PROJ[(size_t)row * PW + P_MO + head * 256 + threadIdx.x]);
            aout[o] = (bf16)f2bf(sigmoidf_(mo) * ((dv * rsqrtf(var + EPS)) * ng[head * 256 + threadIdx.x]));
        }
}
__global__ void __launch_bounds__(256) s_attn(const bf16* PROJ, const float* lq1, const float* lk1, const float* lq2, const float* lk2, const float* sg, bf16* bout) {
    extern __shared__ float sm[];
    float* S = sm; float* Q = sm + 2 * 4 * L; float* red = Q + 2 * 4 * 64;
    const int nqb = L / 4;
    float s1 = 0.f, s2 = 0.f; for (int i = 0; i < 64; ++i) { s1 += lq1[i] * lk1[i]; s2 += lq2[i] * lk2[i]; }
    const float lam = expf(s1) - expf(s2) + 0.2f;
    for (int u = blockIdx.x; u < NB * DH * nqb; u += gridDim.x) {
        const int qb = u % nqb, h = (u / nqb) % DH, b = u / (nqb * DH);
        __syncthreads();
        for (int i = threadIdx.x; i < 2 * 4 * 64; i += 256) { const int d = i & 63, qi = (i >> 6) & 3, m = i >> 8;
            Q[i] = bf2f(PROJ[(size_t)rowof(b, qb * 4 + qi) * PW + P_DQ + h * 128 + m * 64 + d]); }
        __syncthreads();
        for (int kk = threadIdx.x; kk < L; kk += 256) {
            const bf16* kr = PROJ + (size_t)rowof(b, kk) * PW + P_DK + h * 128;
            for (int m = 0; m < 2; ++m) { float a[4] = {0.f, 0.f, 0.f, 0.f};
                for (int d = 0; d < 64; ++d) { const float kv = bf2f(kr[m * 64 + d]); for (int qi = 0; qi < 4; ++qi) a[qi] += Q[(m * 4 + qi) * 64 + d] * kv; }
                for (int qi = 0; qi < 4; ++qi) S[(m * 4 + qi) * L + kk] = a[qi] * 0.125f; }
        }
        __syncthreads();
        for (int r = 0; r < 8; ++r) {
            float mx = -1e30f; for (int kk = threadIdx.x; kk < L; kk += 256) mx = fmaxf(mx, S[r * L + kk]);
            for (int o = 32; o > 0; o >>= 1) mx = fmaxf(mx, __shfl_xor(mx, o));
            __syncthreads(); if ((threadIdx.x & 63) == 0) red[threadIdx.x >> 6] = mx; __syncthreads();
            mx = fmaxf(fmaxf(red[0], red[1]), fmaxf(red[2], red[3]));
            float sum = 0.f; for (int kk = threadIdx.x; kk < L; kk += 256) { const float e = expf(S[r * L + kk] - mx); S[r * L + kk] = e; sum += e; }
            for (int o = 32; o > 0; o >>= 1) sum += __shfl_xor(sum, o);
            __syncthreads(); if ((threadIdx.x & 63) == 0) red[threadIdx.x >> 6] = sum; __syncthreads();
            const float inv = 1.f / (red[0] + red[1] + red[2] + red[3]);
            for (int kk = threadIdx.x; kk < L; kk += 256) S[r * L + kk] *= inv;
        }
        __syncthreads();
        for (int i = threadIdx.x; i < 4 * L; i += 256) S[i] = S[i] - lam * S[4 * L + i];
        __syncthreads();
        const int qi = threadIdx.x >> 6, c2 = (threadIdx.x & 63) * 2;
        float o0 = 0.f, o1 = 0.f;
        for (int kk = 0; kk < L; ++kk) { const float a = S[qi * L + kk]; const unsigned vw = *(const unsigned*)(PROJ + (size_t)rowof(b, kk) * PW + P_DV + h * 128 + c2); o0 += a * bflo(vw); o1 += a * bfhi(vw); }
        float ss = o0 * o0 + o1 * o1; for (int o = 32; o > 0; o >>= 1) ss += __shfl_xor(ss, o);
        const float r = rsqrtf(ss / 128.f + EPS);
        *(unsigned*)(bout + (size_t)rowof(b, qb * 4 + qi) * 1024 + h * 128 + c2) = pk2((o0 * r) * sg[c2] * 0.8f, (o1 * r) * sg[c2 + 1] * 0.8f);
    }
}
__global__ void __launch_bounds__(256) s_convglu(const bf16* UP, const float* fw, bf16* act) {
    for (size_t i = (size_t)blockIdx.x * 256 + threadIdx.x; i < (size_t)NX * FFN; i += (size_t)gridDim.x * 256) {
        const int row = (int)(i / FFN), c = (int)(i % FFN); int b, p; row2bp(row, b, p);
        const size_t rm = (size_t)rowof(b, p - 1) * PW, r0 = (size_t)row * PW, rp = p < L - 1 ? (size_t)rowof(b, p + 1) * PW : 0;
        const float gm = bf2f(UP[rm + c]), g0 = bf2f(UP[r0 + c]), gp = p < L - 1 ? bf2f(UP[rp + c]) : 0.f;
        const float vm = bf2f(UP[rm + FFN + c]), v0 = bf2f(UP[r0 + FFN + c]), vp = p < L - 1 ? bf2f(UP[rp + FFN + c]) : 0.f;
        const float cg = gm * fw[c] + g0 * fw[2 * FFN + c] + gp * fw[4 * FFN + c];
        const float cv = vm * fw[FFN + c] + v0 * fw[2 * FFN + FFN + c] + vp * fw[4 * FFN + FFN + c];
        act[i] = (bf16)f2bf(siluf_(cg) * cv);
    }
}

extern "C" void kernel_launch(void* const* d_in, const int* in_sizes, int n_in, void* d_out, int out_size, void* d_ws, size_t ws_size, hipStream_t stream) {
    static int grid = 0;
    constexpr int ATT_LDS = (2 * 4 * L + 2 * 4 * 64 + 16) * 4;
    if (grid == 0) {
        if (n_in != 20 || ws_size < WS_END || out_size != NX * D) { fprintf(stderr, "kernel_launch: n_in %d ws %zu (need %zu) out %d\n", n_in, ws_size, (size_t)WS_END, out_size); grid = -1; return; }
        int dev = 0, cus = 0;
        if (hipGetDevice(&dev) != hipSuccess || hipDeviceGetAttribute(&cus, hipDeviceAttributeMultiprocessorCount, dev) != hipSuccess) { grid = -1; return; }
        if (hipFuncSetAttribute((const void*)mk_fwd, hipFuncAttributeMaxDynamicSharedMemorySize, LDS_BYTES) != hipSuccess) { fprintf(stderr, "kernel_launch: LDS attr failed\n"); grid = -1; return; }
        if (hipFuncSetAttribute((const void*)s_attn, hipFuncAttributeMaxDynamicSharedMemorySize, ATT_LDS) != hipSuccess) { grid = -1; return; }
        grid = cus;
    }
    if (grid < 0) return;
    (void)hipMemsetAsync((char*)d_ws + WS_CTL, 0, CTL_ZERO_BYTES, stream);
    Args a{};
    for (int i = 0; i < 20; ++i) a.in[i] = (const float*)d_in[i];
    a.out = (float*)d_out; a.ws = (unsigned char*)d_ws;
    unsigned char* ws = (unsigned char*)d_ws;
    const bf16* PROJ = (const bf16*)(ws + WS_P); bf16* HF = (bf16*)(ws + WS_X); bf16* HB = HF + (size_t)MP * 1024; bf16* AOUT = (bf16*)(ws + WS_A); bf16* BOUT = AOUT + (size_t)MP * 1024;
#define FRAME(lo_, hi_) do { a.ph_lo = (lo_); a.ph_hi = (hi_); hipLaunchKernelGGL(mk_fwd, dim3(grid), dim3(NWAVES * 64), LDS_BYTES, stream, a); } while (0)
    FRAME(0, 1); FRAME(1, 2); FRAME(2, 3);
    hipLaunchKernelGGL(s_mlstm, dim3(NB * MH * 2), dim3(1024), 0, stream, PROJ, (const float*)(ws + WS_GATES), (const float*)d_in[I_GBIAS], (const float*)d_in[I_MCONV], HF, HB);
    hipLaunchKernelGGL(s_attn, dim3(4096), dim3(256), ATT_LDS, stream, PROJ, (const float*)d_in[I_LQ1], (const float*)d_in[I_LK1], (const float*)d_in[I_LQ2], (const float*)d_in[I_LK2], (const float*)d_in[I_SG], BOUT);
    hipLaunchKernelGGL(s_mlstm_out, dim3(2048), dim3(256), 0, stream, (const bf16*)HF, (const bf16*)HB, PROJ, (const float*)d_in[I_MNG], AOUT);
    FRAME(3, 4); FRAME(4, 5); FRAME(5, 6);
    hipLaunchKernelGGL(s_convglu, dim3(4096), dim3(256), 0, stream, (const bf16*)(ws + WS_P), (const float*)d_in[I_FCONV], (bf16*)(ws + WS_ACT));
    FRAME(6, 7); FRAME(7, 8);
    const hipError_t le = hipPeekAtLastError();
    if (le != hipSuccess) fprintf(stderr, "kernel_launch: launch failed: %s\n", hipGetErrorName(le));
}
```

```cpp
#include <hip/hip_runtime.h>
#include <cstdio>
#include <cstdint>
#include <cmath>

constexpr int D = 2048, NB = 2, SEQ = 4096, NMETA = 16, L = SEQ + NMETA, NR = NB * L, NX = NB * SEQ, MP = 8448;
constexpr int MH = 4, DH = 8;
constexpr int INW = 11280, PW = 11264, FFN = 5632;
constexpr float EPS = 1e-6f;
constexpr int C_G = 4096;
constexpr int P_MQK = 0, P_MV = 2048, P_MO = 3072, P_DQ = 4096, P_DK = 5120, P_DV = 6144, P_GM = 7168, P_GD = 9216;
__host__ __device__ __forceinline__ int rowof(int b, int p) { return p >= NMETA ? b * SEQ + (p - NMETA) : NX + b * NMETA + p; }
__device__ __forceinline__ void row2bp(int row, int& b, int& p) { if (row < NX) { b = row / SEQ; p = row % SEQ + NMETA; } else { b = ((row - NX) / NMETA) & 1; p = (row - NX) % NMETA; } }

namespace pg8 {
#define PG8_LAS __attribute__((address_space(3)))
typedef unsigned short bf16_t;
typedef short bf16x8 __attribute__((ext_vector_type(8)));
typedef float f32x4 __attribute__((ext_vector_type(4)));
typedef unsigned u32x4 __attribute__((ext_vector_type(4)));
constexpr int BM = 256, BK = 64, HALF = 128, HTB = HALF * BK * 2  , STAGE_BYTES = 8 * HTB, NXCD = 8, WGM = 8;

__host__ __device__ __forceinline__ int lds_byte(int r, int c) { const int st = (r >> 4) * 2 + (c >> 5), rr = r & 15, cc = c & 31, ob = rr * 64 + cc * 2; return st * 1024 + (ob ^ (((ob >> 9) & 1) << 5)); }
__host__ __device__ __forceinline__ void stage_rc(int b, int& R, int& C) { const int st = b / 1024, sb = b % 1024, swz = sb ^ (((sb >> 9) & 1) << 5); R = (st >> 1) * 16 + swz / 64; C = (st & 1) * 32 + (swz % 64) / 2; }
__host__ __device__ __forceinline__ int perm32(int rho) { const int n = rho >> 4, i = rho & 15; return 8 * (i >> 2) + 4 * n + (i & 3); }

struct Unit { int pm, pn, sub; };
struct Gemm { const bf16_t* A; const bf16_t* Bt; int M, N, K; const bf16_t* A2; const bf16_t* Bt2; };

struct StaticOrder {
    int nM, nN, nwg, G, c;
    __host__ __device__ void init(int M, int N, int G_, int c_) { nM = M / BM; nN = N / BM; nwg = nM * nN; G = G_; c = c_; }
    __host__ __device__ bool next(int i, Unit& u) const {
        const long L = (long)i * G + c; if (L >= nwg) return false;
        int wgid = (int)L; { const int q = nwg / NXCD, r = nwg % NXCD, xcd = wgid % NXCD, off = wgid / NXCD; wgid = (xcd < r ? xcd * (q + 1) : r * (q + 1) + (xcd - r) * q) + off; }
        const int nig = WGM * nN, gid = wgid / nig, fm = gid * WGM, gsz = (nM - fm) < WGM ? (nM - fm) : WGM;
        u.pm = fm + ((wgid % nig) % gsz); u.pn = (wgid % nig) / gsz; u.sub = 0; return true;
    }
    __device__ __forceinline__ void a_ready(const Unit&) const {}
    __device__ __forceinline__ void done(const Unit&) const {}
};
__device__ __forceinline__ unsigned cvt_pk_bf16(float lo, float hi) { unsigned r; asm volatile("v_cvt_pk_bf16_f32 %0, %1, %2" : "=v"(r) : "v"(lo), "v"(hi)); return r; }
template <class Epi, class Sched, bool ALIGN_EPI = false, bool SP2 = false>
__device__ __forceinline__ void gemm_phase(PG8_LAS unsigned char* lds, const Gemm g, const Sched& S, const Epi& E) {
    const int tid = threadIdx.x, wid = __builtin_amdgcn_readfirstlane(tid >> 6), lane = tid & 63, wr = wid >> 2, wc = wid & 3, fr = lane & 15, fq = lane >> 4;
    const int K = g.K, nt = K / BK;
    unsigned voffA[2], voffB[2];
#pragma unroll
    for (int i = 0; i < 2; ++i) { int R, C; stage_rc(tid * 16 + i * 8192, R, C); const int Rb = Epi::PERM ? ((R & ~31) + perm32(R & 31)) : R;
        voffA[i] = (unsigned)(R * K + C) * 2u; voffB[i] = (unsigned)(Rb * K + C) * 2u; }
    const size_t kstep = (size_t)(BK * 2);
    const size_t hstep = (size_t)HALF * K * 2;
    const size_t tstep = 2 * hstep;
    const unsigned ldsw = (unsigned)wid * 1024u;
    const int aoff = lds_byte(wr * 64 + fr, fq * 8), boff = lds_byte(wc * 32 + fr, fq * 8);
#define PG8_SA(b, h) (((b) * 2 + (h)) * HTB)
#define PG8_SB(b, h) ((4 + (b) * 2 + (h)) * HTB)
#define PG8_STAGE(bufoff, gbase, voff) do { _Pragma("unroll") for (int _i = 0; _i < 2; ++_i) \
        __builtin_amdgcn_global_load_lds((const unsigned*)((const char*)(gbase) + (voff)[_i]), (PG8_LAS unsigned*)(lds + (bufoff) + ldsw + _i * 8192), 16, 0, 0); } while (0)
#define PG8_LDA(dst, b, h) do { _Pragma("unroll") for (int m = 0; m < 4; ++m) _Pragma("unroll") for (int k = 0; k < 2; ++k) dst[m][k] = *(const PG8_LAS bf16x8*)(lds + PG8_SA(b, h) + aoff + m * 2048 + k * 1024); } while (0)
#define PG8_LDB(dst, b, h) do { _Pragma("unroll") for (int n = 0; n < 2; ++n) _Pragma("unroll") for (int k = 0; k < 2; ++k) dst[n][k] = *(const PG8_LAS bf16x8*)(lds + PG8_SB(b, h) + boff + n * 2048 + k * 1024); } while (0)
#define PG8_MMA(ai, bj, At, Bt) do { __builtin_amdgcn_s_setprio(1); _Pragma("unroll") for (int m = 0; m < 4; ++m) _Pragma("unroll") for (int n = 0; n < 2; ++n) _Pragma("unroll") for (int k = 0; k < 2; ++k) \
        acc[ai][bj][m][n] = __builtin_amdgcn_mfma_f32_16x16x32_bf16(Bt[n][k], At[m][k], acc[ai][bj][m][n], 0, 0, 0); __builtin_amdgcn_s_setprio(0); } while (0)
#define PG8_WAIT_V(n) asm volatile("s_waitcnt vmcnt(" #n ")" ::: "memory")
#define PG8_WAIT_L(n) asm volatile("s_waitcnt lgkmcnt(" #n ")" ::: "memory")
#define PG8_BAR __builtin_amdgcn_s_barrier()
#define PG8_SCHED __builtin_amdgcn_sched_barrier(0)
    Unit cur, nxt; int ui = 0;
    if (!S.next(0, cur)) return;
    f32x4 acc[2][2][4][2];
#pragma unroll
    for (int a = 0; a < 2; ++a)
#pragma unroll
        for (int b = 0; b < 2; ++b)
#pragma unroll
            for (int m = 0; m < 4; ++m)
#pragma unroll
                for (int n = 0; n < 2; ++n) acc[a][b][m][n] = (f32x4){0.f, 0.f, 0.f, 0.f};
    bf16x8 At[4][2], B0[2][2], B1[2][2];
    const char* cA = (const char*)(cur.sub ? g.A2 : g.A) + (size_t)cur.pm * tstep; const char* cB = (const char*)(cur.sub ? g.Bt2 : g.Bt) + (size_t)cur.pn * tstep;
    S.a_ready(cur);
    if constexpr (SP2) {
        PG8_STAGE(PG8_SB(0, 0), cB, voffB); PG8_STAGE(PG8_SB(0, 1), cB + hstep, voffB); PG8_STAGE(PG8_SA(0, 0), cA, voffA); PG8_STAGE(PG8_SA(0, 1), cA + hstep, voffA);
        if (wr == 1) PG8_BAR;
        PG8_WAIT_V(2); PG8_BAR;
        PG8_STAGE(PG8_SB(1, 0), cB + kstep, voffB); PG8_STAGE(PG8_SA(1, 0), cA + kstep, voffA); PG8_STAGE(PG8_SB(1, 1), cB + hstep + kstep, voffB);
        PG8_WAIT_V(6); PG8_BAR;
    } else {
        PG8_STAGE(PG8_SB(0, 0), cB, voffB); PG8_STAGE(PG8_SA(0, 0), cA, voffA); PG8_STAGE(PG8_SB(0, 1), cB + hstep, voffB); PG8_STAGE(PG8_SA(0, 1), cA + hstep, voffA);
        if (wr == 1) PG8_BAR;
        PG8_WAIT_V(4); PG8_BAR;
        PG8_STAGE(PG8_SB(1, 0), cB + kstep, voffB); PG8_STAGE(PG8_SA(1, 0), cA + kstep, voffA); PG8_STAGE(PG8_SB(1, 1), cB + hstep + kstep, voffB);
        PG8_WAIT_V(6); PG8_BAR;
    }
    for (;;) {
        const bool has_next = S.next(ui + 1, nxt);
        const char* nA = has_next ? (const char*)(nxt.sub ? g.A2 : g.A) + (size_t)nxt.pm * tstep : cA; const char* nB = has_next ? (const char*)(nxt.sub ? g.Bt2 : g.Bt) + (size_t)nxt.pn * tstep : cB;
        for (int t = 0; t < nt; t += 2) {
            const bool last = (t == nt - 2);
            const char* a1 = cA + (size_t)(t + 1) * kstep;
            const char* a2 = last ? nA : cA + (size_t)(t + 2) * kstep; const char* b2 = last ? nB : cB + (size_t)(t + 2) * kstep;
            const char* a3 = a2 + kstep; const char* b3 = b2 + kstep;
            if (last && has_next) S.a_ready(nxt);
            if constexpr (SP2) {
            PG8_LDB(B0, 0, 0); PG8_LDB(B1, 0, 1); PG8_SCHED; PG8_LDA(At, 0, 0); PG8_STAGE(PG8_SA(1, 1), a1 + hstep, voffA);
            PG8_WAIT_V(8); PG8_WAIT_L(0); PG8_BAR; PG8_MMA(0, 0, At, B0); PG8_MMA(0, 1, At, B1); PG8_BAR; PG8_SCHED;
            PG8_LDA(At, 0, 1); PG8_STAGE(PG8_SB(0, 0), b2, voffB); PG8_STAGE(PG8_SB(0, 1), b2 + hstep, voffB); PG8_STAGE(PG8_SA(0, 0), a2, voffA);
            PG8_WAIT_V(8); PG8_WAIT_L(0); PG8_BAR; PG8_MMA(1, 0, At, B0); PG8_MMA(1, 1, At, B1); PG8_BAR; PG8_SCHED;
            PG8_LDB(B0, 1, 0); PG8_LDB(B1, 1, 1); PG8_SCHED; PG8_LDA(At, 1, 0); PG8_STAGE(PG8_SA(0, 1), a2 + hstep, voffA);
            PG8_WAIT_V(8); PG8_WAIT_L(0); PG8_BAR; PG8_MMA(0, 0, At, B0); PG8_MMA(0, 1, At, B1); PG8_BAR; PG8_SCHED;
            PG8_LDA(At, 1, 1); PG8_STAGE(PG8_SB(1, 0), b3, voffB); PG8_STAGE(PG8_SB(1, 1), b3 + hstep, voffB); PG8_STAGE(PG8_SA(1, 0), a3, voffA);
            PG8_WAIT_V(8); PG8_WAIT_L(0); PG8_BAR; PG8_MMA(1, 0, At, B0); PG8_MMA(1, 1, At, B1); PG8_BAR; PG8_SCHED;
            } else {
            PG8_LDB(B0, 0, 0); PG8_SCHED; PG8_LDA(At, 0, 0); PG8_STAGE(PG8_SA(1, 1), a1 + hstep, voffA);
            PG8_WAIT_L(8); PG8_BAR; PG8_WAIT_L(0); PG8_MMA(0, 0, At, B0); PG8_BAR; PG8_SCHED;
            PG8_LDB(B1, 0, 1); PG8_STAGE(PG8_SB(0, 0), b2, voffB);
            PG8_BAR; PG8_WAIT_L(0); PG8_MMA(0, 1, At, B1); PG8_BAR;
            PG8_LDA(At, 0, 1); PG8_STAGE(PG8_SA(0, 0), a2, voffA);
            PG8_BAR; PG8_WAIT_L(0); PG8_MMA(1, 0, At, B0); PG8_BAR; PG8_SCHED;
            PG8_STAGE(PG8_SB(0, 1), b2 + hstep, voffB);
            PG8_WAIT_V(6); PG8_BAR; PG8_MMA(1, 1, At, B1); PG8_BAR;
            PG8_LDB(B0, 1, 0); PG8_SCHED; PG8_LDA(At, 1, 0); PG8_STAGE(PG8_SA(0, 1), a2 + hstep, voffA);
            PG8_WAIT_L(8); PG8_BAR; PG8_WAIT_L(0); PG8_MMA(0, 0, At, B0); PG8_BAR; PG8_SCHED;
            PG8_LDB(B1, 1, 1); PG8_STAGE(PG8_SB(1, 0), b3, voffB);
            PG8_BAR; PG8_WAIT_L(0); PG8_MMA(0, 1, At, B1); PG8_BAR;
            PG8_LDA(At, 1, 1); PG8_STAGE(PG8_SA(1, 0), a3, voffA);
            PG8_BAR; PG8_WAIT_L(0); PG8_MMA(1, 0, At, B0); PG8_BAR; PG8_SCHED;
            PG8_STAGE(PG8_SB(1, 1), b3 + hstep, voffB);
            PG8_WAIT_V(6); PG8_BAR; PG8_MMA(1, 1, At, B1); PG8_BAR;
            }
        }
        if constexpr (ALIGN_EPI) { if (wr == 0) PG8_BAR; }
        if constexpr (!Epi::AFTER_DRAIN) { E(acc, cur, wr, wc, fr, fq); S.done(cur); }
        if (!has_next) break;
        if (nxt.sub == 0) {
#pragma unroll
        for (int a = 0; a < 2; ++a)
#pragma unroll
            for (int b = 0; b < 2; ++b)
#pragma unroll
                for (int m = 0; m < 4; ++m)
#pragma unroll
                    for (int n = 0; n < 2; ++n) acc[a][b][m][n] = (f32x4){0.f, 0.f, 0.f, 0.f};
        }
        cur = nxt; cA = nA; cB = nB; ++ui;
        if constexpr (ALIGN_EPI) { if (wr == 1) PG8_BAR; }
    }
    PG8_WAIT_V(0);
    if constexpr (!ALIGN_EPI) { if (wr == 0) PG8_BAR; }
    PG8_BAR;
    if constexpr (Epi::AFTER_DRAIN) { E.fused(acc, cur, wr, wc, fr, fq, lds, wid, lane); S.done(cur); }
#undef PG8_SA
#undef PG8_SB
#undef PG8_STAGE
#undef PG8_LDA
#undef PG8_LDB
#undef PG8_MMA
#undef PG8_WAIT_V
#undef PG8_WAIT_L
#undef PG8_BAR
#undef PG8_SCHED
}
}

#define GAS __attribute__((address_space(1)))
#define LAS __attribute__((address_space(3)))
typedef unsigned short bf16;
typedef unsigned v4u __attribute__((ext_vector_type(4)));
typedef unsigned v2u __attribute__((ext_vector_type(2)));
typedef float f32x4 __attribute__((ext_vector_type(4)));
typedef GAS unsigned gu32;
#define RLX_AGENT __ATOMIC_RELAXED, __HIP_MEMORY_SCOPE_AGENT
#define LDS_WAIT() asm volatile("s_waitcnt lgkmcnt(0)" ::: "memory")
#define VM_WAIT() asm volatile("s_waitcnt vmcnt(0)" ::: "memory")
__device__ __forceinline__ unsigned f2bf(float f) { unsigned u = __builtin_bit_cast(unsigned, f); return (u + 0x7fffu + ((u >> 16) & 1u)) >> 16; }
__device__ __forceinline__ unsigned pk2(float lo, float hi) { return f2bf(lo) | (f2bf(hi) << 16); }
__device__ __forceinline__ float bf2f(unsigned v) { return __builtin_bit_cast(float, v << 16); }
__device__ __forceinline__ float bflo(unsigned w) { return __builtin_bit_cast(float, w << 16); }
__device__ __forceinline__ float bfhi(unsigned w) { return __builtin_bit_cast(float, w & 0xffff0000u); }
__device__ __forceinline__ float sigmoidf_(float x) { return 1.f / (1.f + __expf(-x)); }
__device__ __forceinline__ float siluf_(float x) { return x / (1.f + __expf(-x)); }
__device__ __forceinline__ float logsigmoidf_(float x) { return fminf(x, 0.f) - log1pf(expf(-fabsf(x))); }
__device__ __forceinline__ float wave_sum(float v) {
#pragma unroll
    for (int o = 1; o < 64; o <<= 1) v += __shfl_xor(v, o);
    return v;
}

constexpr size_t MiB = 1u << 20;
constexpr size_t WS_CTL = 0, CTL_ZERO_BYTES = 1 * MiB;
constexpr size_t WS_GATES = 1 * MiB;
constexpr size_t WS_R1 = 1 * MiB + 640 * 1024;
constexpr size_t WS_ROPE = 2 * MiB;
constexpr size_t WS_WA = 3 * MiB, WS_WB = 7 * MiB, WS_WOUT = 11 * MiB, WS_WDOWN = 19 * MiB;
constexpr size_t WS_W1 = 41 * MiB;
constexpr size_t WS_A = 85 * MiB;
constexpr size_t WS_X = 118 * MiB;
constexpr size_t WS_P = 170 * MiB;
constexpr size_t WS_ACT = 41 * MiB;
constexpr size_t WS_END = 352 * MiB;
static_assert(WS_P + (size_t)MP * PW * 2 <= WS_END && WS_ACT + (size_t)NX * FFN * 2 <= WS_P && WS_X + (size_t)MP * 2048 * 2 <= WS_P, "d_ws map");
static_assert(WS_WDOWN + (size_t)2048 * FFN * 2 <= WS_W1 && WS_W1 + (size_t)PW * 2048 * 2 <= WS_A && WS_A + (size_t)MP * 2048 * 2 <= WS_X, "d_ws map 2");
constexpr int CW_BAR = 4096;
constexpr int CW_SS2 = 16384, CW_SS3 = 32768;
constexpr int CW_WQ = 49152;

constexpr int RING_OFF = 0, RING_BYTES = 131072;
constexpr int LDSCTL_OFF = RING_BYTES, MISC_OFF = LDSCTL_OFF + 320;
constexpr int LDS_BYTES = 147456;
constexpr int NWAVES = 8;

#define XB_TMO      128
#define XB_XCNT(j)  (256  + 64 * (j))
#define XB_XSUB(j)  (1280 + 64 * (j))
#define XB_XGEN(j)  (2304 + 64 * (j))
#define XB_TOP      3328
#define XB_TOPGEN   3392
#define XCD_BAR_WORDS 3456
#define XB_SPIN_CAP (1u << 18)

__device__ __forceinline__ unsigned xb_ld(unsigned* p)              { return __hip_atomic_load(p, __ATOMIC_RELAXED, __HIP_MEMORY_SCOPE_AGENT); }
__device__ __forceinline__ unsigned xb_add(unsigned* p, unsigned v) { return __hip_atomic_fetch_add(p, v, __ATOMIC_RELAXED, __HIP_MEMORY_SCOPE_AGENT); }
__device__ __forceinline__ unsigned xb_xcc_id() { return (unsigned)__builtin_amdgcn_s_getreg((3 << 11) | 20) & 0xFu; }
#define XB_SPIN(cond, bar) do { unsigned _sp = 0; while (cond) { __builtin_amdgcn_s_sleep(1); \
    if ((++_sp & 255u) == 0u) { if (xb_ld(&(bar)[XB_TMO])) break; if (_sp > XB_SPIN_CAP) { atomicAdd(&(bar)[XB_TMO], 1u); break; } } } } while (0)

struct XcdBarrier {
    unsigned* bar; unsigned x;
    volatile LAS unsigned* st;
};

__device__ __forceinline__ XcdBarrier xcd_barrier_post(unsigned* bar, volatile LAS unsigned* st) {
    XcdBarrier b; b.bar = bar; b.x = xb_xcc_id(); b.st = st;
    if (threadIdx.x == 0) (void)xb_add(&bar[XB_XCNT(b.x)], 1u);
    return b;
}
__device__ __forceinline__ void xcd_barrier_complete(unsigned* bar, unsigned x, unsigned& nloc, unsigned& nx) {
    const unsigned G = gridDim.x * gridDim.y * gridDim.z;
    unsigned sum, cnt, mine, sp = 0u;
    for (;;) {
        sum = 0u; cnt = 0u; mine = 0u;
#pragma unroll
        for (unsigned j = 0; j < 16; ++j) { const unsigned c = xb_ld(&bar[XB_XCNT(j)]); sum += c; cnt += (c > 0u) ? 1u : 0u; mine = (j == x) ? c : mine; }
        if (sum == G) break;
        __builtin_amdgcn_s_sleep(1);
        if ((++sp & 255u) == 0u) { if (xb_ld(&bar[XB_TMO])) break; if (sp > XB_SPIN_CAP) { atomicAdd(&bar[XB_TMO], 1u); break; } }
    }
    nloc = mine > 0u ? mine : 1u; nx = cnt > 0u ? cnt : 1u;
}

__device__ __forceinline__ void xcd_barrier(const XcdBarrier& b) {
    asm volatile("s_waitcnt vmcnt(0)" ::: "memory");
    __syncthreads();
    if (threadIdx.x == 0) {
        unsigned* bar = b.bar;
        __builtin_amdgcn_s_waitcnt(0);
        unsigned nloc = b.st[0], nx = b.st[1];
        if (nloc == 0u) { xcd_barrier_complete(bar, b.x, nloc, nx); b.st[0] = nloc; b.st[1] = nx; }
        const unsigned old = xb_add(&bar[XB_XSUB(b.x)], 1u);
        const unsigned gen = old / nloc;
        if (old + 1u == (gen + 1u) * nloc) {
            __builtin_amdgcn_fence(__ATOMIC_RELEASE, "agent");
            asm volatile("s_waitcnt vmcnt(0)" ::: "memory");
            const unsigned og = xb_add(&bar[XB_TOP], 1u);
            const unsigned tg = og / nx;
            if (og + 1u == (tg + 1u) * nx) xb_add(&bar[XB_TOPGEN], 1u);
            else XB_SPIN(xb_ld(&bar[XB_TOPGEN]) == tg, bar);
            __builtin_amdgcn_fence(__ATOMIC_ACQUIRE, "agent");
            xb_add(&bar[XB_XGEN(b.x)], 1u);
            asm volatile("s_waitcnt vmcnt(0)" ::: "memory");
        } else {
            XB_SPIN(xb_ld(&bar[XB_XGEN(b.x)]) == gen, bar);
            __builtin_amdgcn_fence(__ATOMIC_ACQUIRE, "agent");
            asm volatile("s_waitcnt vmcnt(0)" ::: "memory");
        }
    }
    __syncthreads();
}

namespace pg8 {
struct EpiProj {
    static constexpr bool PERM = true, AFTER_DRAIN = false;
    bf16_t* O; const float* r1; const float* rope;
    __device__ __forceinline__ void operator()(f32x4 (&acc)[2][2][4][2], const Unit& u, int wr, int wc, int fr, int fq) const {
        const int row0 = u.pm * BM + wr * 64 + fr, col0 = u.pn * BM + wc * 32 + 8 * fq;
        const bool ropet = (u.pn >= P_DQ / 256) && (u.pn < P_DV / 256) && ((wc & 1) == 0);
#pragma unroll
        for (int ai = 0; ai < 2; ++ai)
#pragma unroll
            for (int m = 0; m < 4; ++m) {
                const int row = row0 + ai * HALF + m * 16; const float rs = r1[row];
                f32x4 cs[4];
                if (ropet) { int b, p; row2bp(row < NR ? row : 0, b, p); const f32x4* rp = (const f32x4*)(rope + (size_t)p * 16);
#pragma unroll
                    for (int q = 0; q < 4; ++q) cs[q] = rp[q]; }
                bf16_t* rowp = O + (size_t)row * PW + col0;
#pragma unroll
                for (int bj = 0; bj < 2; ++bj) {
                    f32x4 v0 = acc[ai][bj][m][0] * rs, v1 = acc[ai][bj][m][1] * rs;
                    if (ropet) {
                        f32x4 o0, o1;
#pragma unroll
                        for (int e = 0; e < 4; ++e) { o0[e] = __shfl_xor(v0[e], 16); o1[e] = __shfl_xor(v1[e], 16); }
                        const float sg = (fq == 0) ? -1.f : 1.f;
                        if (fq < 2) {
                            v0 = (f32x4){v0[0] * cs[0][0] + sg * o0[0] * cs[0][1], v0[1] * cs[0][2] + sg * o0[1] * cs[0][3], v0[2] * cs[1][0] + sg * o0[2] * cs[1][1], v0[3] * cs[1][2] + sg * o0[3] * cs[1][3]};
                            v1 = (f32x4){v1[0] * cs[2][0] + sg * o1[0] * cs[2][1], v1[1] * cs[2][2] + sg * o1[1] * cs[2][3], v1[2] * cs[3][0] + sg * o1[2] * cs[3][1], v1[3] * cs[3][2] + sg * o1[3] * cs[3][3]};
                        }
                    }
                    u32x4 w; w.x = cvt_pk_bf16(v0[0], v0[1]); w.y = cvt_pk_bf16(v0[2], v0[3]); w.z = cvt_pk_bf16(v1[0], v1[1]); w.w = cvt_pk_bf16(v1[2], v1[3]);
                    *(u32x4*)(rowp + bj * HALF) = w;
                }
            }
    }
};
struct EpiMerged {
    static constexpr bool PERM = true, AFTER_DRAIN = false;
    const bf16_t* P; bf16_t* O;
    __device__ __forceinline__ void operator()(f32x4 (&acc)[2][2][4][2], const Unit& u, int wr, int wc, int fr, int fq) const {
        const int row0 = u.pm * BM + wr * 64 + fr, col0 = u.pn * BM + wc * 32 + 8 * fq;
#pragma unroll
        for (int ai = 0; ai < 2; ++ai)
#pragma unroll
            for (int m = 0; m < 4; ++m) {
                const int row = row0 + ai * HALF + m * 16;
#pragma unroll
                for (int bj = 0; bj < 2; ++bj) {
                    const int col = col0 + bj * HALF;
                    const u32x4 gd = *(const u32x4*)(P + (size_t)row * PW + P_GD + col);
                    float ed[8];
#pragma unroll
                    for (int q = 0; q < 4; ++q) { ed[2 * q] = __expf(-bflo(gd[q])); ed[2 * q + 1] = __expf(-bfhi(gd[q])); }
                    if (u.sub == 0) {
                        const u32x4 gm = *(const u32x4*)(P + (size_t)row * PW + P_GM + col);
#pragma unroll
                        for (int q = 0; q < 4; ++q) { const float em0 = __expf(-bflo(gm[q])), em1 = __expf(-bfhi(gm[q]));
                            const float r0 = (1.f + ed[2 * q]) / (1.f + em0), r1_ = (1.f + ed[2 * q + 1]) / (1.f + em1);
                            if (q < 2) { acc[ai][bj][m][0][2 * q] *= r0; acc[ai][bj][m][0][2 * q + 1] *= r1_; } else { acc[ai][bj][m][1][2 * q - 4] *= r0; acc[ai][bj][m][1][2 * q - 3] *= r1_; } }
                    } else {
                        float o[8];
#pragma unroll
                        for (int e = 0; e < 4; ++e) { o[e] = acc[ai][bj][m][0][e] / (1.f + ed[e]); o[4 + e] = acc[ai][bj][m][1][e] / (1.f + ed[4 + e]); }
                        u32x4 w; w.x = cvt_pk_bf16(o[0], o[1]); w.y = cvt_pk_bf16(o[2], o[3]); w.z = cvt_pk_bf16(o[4], o[5]); w.w = cvt_pk_bf16(o[6], o[7]);
                        *(u32x4*)(O + (size_t)row * 2048 + col) = w;
                    }
                }
            }
    }
};
struct EpiOut {
    static constexpr bool PERM = true, AFTER_DRAIN = false;
    const float* x; const float* meta; const float* g2; float* out; bf16_t* A2; float* ss;
    __device__ __forceinline__ void operator()(f32x4 (&acc)[2][2][4][2], const Unit& u, int wr, int wc, int fr, int fq) const {
        const int row0 = u.pm * BM + wr * 64 + fr, col0 = u.pn * BM + wc * 32 + 8 * fq;
        f32x4 gv[2][2];
#pragma unroll
        for (int bj = 0; bj < 2; ++bj) { gv[bj][0] = *(const f32x4*)(g2 + col0 + bj * HALF); gv[bj][1] = *(const f32x4*)(g2 + col0 + bj * HALF + 4); }
#pragma unroll
        for (int ai = 0; ai < 2; ++ai)
#pragma unroll
            for (int m = 0; m < 4; ++m) {
                const int row = row0 + ai * HALF + m * 16;
                const float* hr = row < NX ? x + (size_t)row * D : meta + (size_t)((row - NX) & 15) * D;
                float s = 0.f;
#pragma unroll
                for (int bj = 0; bj < 2; ++bj) {
                    const int col = col0 + bj * HALF;
                    const f32x4 h0 = *(const f32x4*)(hr + col) + acc[ai][bj][m][0], h1 = *(const f32x4*)(hr + col + 4) + acc[ai][bj][m][1];
                    s += (h0[0] * h0[0] + h0[1] * h0[1]) + (h0[2] * h0[2] + h0[3] * h0[3]) + (h1[0] * h1[0] + h1[1] * h1[1]) + (h1[2] * h1[2] + h1[3] * h1[3]);
                    if (row < NX) { *(f32x4*)(out + (size_t)row * D + col) = h0; *(f32x4*)(out + (size_t)row * D + col + 4) = h1; }
                    const f32x4 a0 = h0 * gv[bj][0], a1 = h1 * gv[bj][1];
                    u32x4 w; w.x = cvt_pk_bf16(a0[0], a0[1]); w.y = cvt_pk_bf16(a0[2], a0[3]); w.z = cvt_pk_bf16(a1[0], a1[1]); w.w = cvt_pk_bf16(a1[2], a1[3]);
                    *(u32x4*)(A2 + (size_t)row * D + col) = w;
                }
                s += __shfl_xor(s, 16); s += __shfl_xor(s, 32);
                if (fq == 0) atomicAdd(ss + row, s);
            }
    }
};
struct EpiUp {
    static constexpr bool PERM = true, AFTER_DRAIN = false;
    bf16_t* O; const float* ss;
    __device__ __forceinline__ void operator()(f32x4 (&acc)[2][2][4][2], const Unit& u, int wr, int wc, int fr, int fq) const {
        const int row0 = u.pm * BM + wr * 64 + fr, col0 = u.pn * BM + wc * 32 + 8 * fq;
#pragma unroll
        for (int ai = 0; ai < 2; ++ai)
#pragma unroll
            for (int m = 0; m < 4; ++m) {
                const int row = row0 + ai * HALF + m * 16; const float rs = rsqrtf(ss[row] * (1.f / D) + EPS);
                bf16_t* rowp = O + (size_t)row * PW + col0;
#pragma unroll
                for (int bj = 0; bj < 2; ++bj) { const f32x4 v0 = acc[ai][bj][m][0] * rs, v1 = acc[ai][bj][m][1] * rs;
                    u32x4 w; w.x = cvt_pk_bf16(v0[0], v0[1]); w.y = cvt_pk_bf16(v0[2], v0[3]); w.z = cvt_pk_bf16(v1[0], v1[1]); w.w = cvt_pk_bf16(v1[2], v1[3]);
                    *(u32x4*)(rowp + bj * HALF) = w; }
            }
    }
};
struct EpiDown {
    static constexpr bool PERM = true, AFTER_DRAIN = false;
    float* out; float* ss;
    __device__ __forceinline__ void operator()(f32x4 (&acc)[2][2][4][2], const Unit& u, int wr, int wc, int fr, int fq) const {
        const int row0 = u.pm * BM + wr * 64 + fr, col0 = u.pn * BM + wc * 32 + 8 * fq;
#pragma unroll
        for (int ai = 0; ai < 2; ++ai)
#pragma unroll
            for (int m = 0; m < 4; ++m) {
                const int row = row0 + ai * HALF + m * 16; float s = 0.f;
#pragma unroll
                for (int bj = 0; bj < 2; ++bj) {
                    float* p = out + (size_t)row * D + col0 + bj * HALF;
                    const f32x4 h0 = *(const f32x4*)p + acc[ai][bj][m][0], h1 = *(const f32x4*)(p + 4) + acc[ai][bj][m][1];
                    s += (h0[0] * h0[0] + h0[1] * h0[1]) + (h0[2] * h0[2] + h0[3] * h0[3]) + (h1[0] * h1[0] + h1[1] * h1[1]) + (h1[2] * h1[2] + h1[3] * h1[3]);
                    *(f32x4*)p = h0; *(f32x4*)(p + 4) = h1;
                }
                s += __shfl_xor(s, 16); s += __shfl_xor(s, 32);
                if (fq == 0) atomicAdd(ss + row, s);
            }
    }
};
struct PairOrder {
    StaticOrder S;
    __device__ bool next(int i, Unit& u) const { const bool ok = S.next(i >> 1, u); u.sub = i & 1; return ok; }
    __device__ __forceinline__ void a_ready(const Unit&) const {}
    __device__ __forceinline__ void done(const Unit&) const {}
};
}

namespace att {
using bf16x8 = __attribute__((ext_vector_type(8))) short;
using s16x4  = __attribute__((ext_vector_type(4))) short;
using f32x16 = __attribute__((ext_vector_type(16))) float;
using u32x4  = __attribute__((ext_vector_type(4))) unsigned;
constexpr int KVBLK = 64, NT = 65;
constexpr float SCALE = 0.125f, THR = 8.f;
constexpr int SHM_V = KVBLK * 128 * 2, SHM_K = KVBLK * 128 * 2, SHM_ATTN = 2 * SHM_V + 2 * SHM_K + 8 * 64 * 4;
#define KSWZ(row, colB) ((row) * 256 + ((colB) ^ (((row) & 7) << 4)))
#define SBAR() __builtin_amdgcn_sched_barrier(0)
__device__ __forceinline__ int crow(int r, int hi) { return (r & 3) + 8 * (r >> 2) + 4 * hi; }
__device__ __forceinline__ unsigned cvtpk(float lo, float hi) { unsigned r; asm volatile("v_cvt_pk_bf16_f32 %0, %1, %2" : "=v"(r) : "v"(lo), "v"(hi)); return r; }
__device__ __forceinline__ void partialSM(f32x16& p0, f32x16& p1, float& m_reg, float& mn, float& alpha) {
  constexpr float C = SCALE * 1.4426950408889634f;
  float pmax = p0[0];
#pragma unroll
  for (int r = 1; r < 16; ++r) pmax = fmaxf(pmax, p0[r]);
#pragma unroll
  for (int r = 0; r < 16; ++r) pmax = fmaxf(pmax, p1[r]);
  { auto rr = __builtin_amdgcn_permlane32_swap(__float_as_uint(pmax), __float_as_uint(pmax), false, false);
    pmax = fmaxf(__uint_as_float(rr[0]), __uint_as_float(rr[1])); }
  if (__builtin_expect(__all(pmax - m_reg <= THR / SCALE), 1)) { mn = m_reg; alpha = 1.f; }
  else { mn = fmaxf(m_reg, pmax); alpha = __builtin_amdgcn_exp2f((m_reg - mn) * C); m_reg = mn; }
  float mnC = -mn * C;
#pragma unroll
  for (int r = 0; r < 16; ++r) p0[r] = fmaf(p0[r], C, mnC);
#pragma unroll
  for (int r = 0; r < 16; ++r) p1[r] = fmaf(p1[r], C, mnC);
#pragma unroll
  for (int r = 0; r < 16; ++r) p0[r] = __builtin_amdgcn_exp2f(p0[r]);
}
__device__ __forceinline__ void finishSM(f32x16& p0, f32x16& p1, float alpha, float& l_reg, bf16x8& pa0, bf16x8& pa1, bf16x8& pa2, bf16x8& pa3) {
#pragma unroll
  for (int r = 0; r < 16; ++r) p1[r] = __builtin_amdgcn_exp2f(p1[r]);
  float ps = 0;
#pragma unroll
  for (int r = 0; r < 16; ++r) ps += p0[r];
#pragma unroll
  for (int r = 0; r < 16; ++r) ps += p1[r];
  { auto rr = __builtin_amdgcn_permlane32_swap(__float_as_uint(ps), __float_as_uint(ps), false, false);
    ps = __uint_as_float(rr[0]) + __uint_as_float(rr[1]); }
  l_reg = l_reg * alpha + ps;
#define PK4(P, BASE, OUT) do { unsigned a0 = cvtpk(P[BASE + 0], P[BASE + 1]), a1 = cvtpk(P[BASE + 2], P[BASE + 3]);   \
    unsigned b0 = cvtpk(P[BASE + 4], P[BASE + 5]), b1 = cvtpk(P[BASE + 6], P[BASE + 7]);                              \
    auto r0 = __builtin_amdgcn_permlane32_swap(a0, b0, false, false); auto r1 = __builtin_amdgcn_permlane32_swap(a1, b1, false, false); \
    u32x4 w = {r0[0], r1[0], r0[1], r1[1]}; OUT = *reinterpret_cast<bf16x8*>(&w); } while (0)
  PK4(p0, 0, pa0); PK4(p0, 8, pa1); PK4(p1, 0, pa2); PK4(p1, 8, pa3);
#undef PK4
}
__device__ __forceinline__ void qkt(f32x16& p0, f32x16& p1, const char* Ks, const bf16x8* qr, int r32, int hi, int mcolB) {
  p0 = f32x16{}; p1 = f32x16{};
#pragma unroll
  for (int d0 = 0; d0 < 4; ++d0) { const int cb = mcolB + (d0 * 16 + hi * 8) * 2;
    bf16x8 b0 = *reinterpret_cast<const bf16x8*>(Ks + KSWZ(r32, cb));
    bf16x8 b1 = *reinterpret_cast<const bf16x8*>(Ks + KSWZ(32 + r32, cb));
    p0 = __builtin_amdgcn_mfma_f32_32x32x16_bf16(b0, qr[d0], p0, 0, 0, 0);
    p1 = __builtin_amdgcn_mfma_f32_32x32x16_bf16(b1, qr[d0], p1, 0, 0, 0); }
}
__device__ __forceinline__ int v_st(int k, int c) { const int kk = (k & ~0xC) | ((k & 4) << 1) | ((k & 8) >> 1); return ((kk >> 3) * 4 + (c >> 5)) * 512 + ((kk & 7) * 32 + (c & 31)) * 2; }
__device__ __forceinline__ int v_rd_base(int lane) { return ((lane & 3) << 3) | (((lane >> 2) & 3) << 6) | (((lane >> 4) & 1) << 5) | (((lane >> 5) & 1) << 8); }
constexpr int v_rd_off(int d0, int ks, int half) { return d0 * 512 + ks * 4096 + half * 2048; }
template <int OFF> __device__ __forceinline__ s16x4 tr_read(int vb) {
  s16x4 r; asm volatile("ds_read_b64_tr_b16 %0, %1 offset:%2" : "=&v"(r) : "v"(vb), "i"(OFF) : "memory"); return r;
}
template <int D0> __device__ __forceinline__ void pv_one(f32x16& od, int vb, bf16x8 pa0, bf16x8 pa1, bf16x8 pa2, bf16x8 pa3) {
  const s16x4 l0 = tr_read<v_rd_off(D0, 0, 0)>(vb), h0 = tr_read<v_rd_off(D0, 0, 1)>(vb), l1 = tr_read<v_rd_off(D0, 1, 0)>(vb), h1 = tr_read<v_rd_off(D0, 1, 1)>(vb);
  const s16x4 l2 = tr_read<v_rd_off(D0, 2, 0)>(vb), h2 = tr_read<v_rd_off(D0, 2, 1)>(vb), l3 = tr_read<v_rd_off(D0, 3, 0)>(vb), h3 = tr_read<v_rd_off(D0, 3, 1)>(vb);
  asm volatile("s_waitcnt lgkmcnt(0)" ::: "memory"); SBAR();
#define PK(L_, H_) (bf16x8){L_[0], L_[1], L_[2], L_[3], H_[0], H_[1], H_[2], H_[3]}
  od = __builtin_amdgcn_mfma_f32_32x32x16_bf16(pa0, PK(l0, h0), od, 0, 0, 0);
  od = __builtin_amdgcn_mfma_f32_32x32x16_bf16(pa1, PK(l1, h1), od, 0, 0, 0);
  od = __builtin_amdgcn_mfma_f32_32x32x16_bf16(pa2, PK(l2, h2), od, 0, 0, 0);
  od = __builtin_amdgcn_mfma_f32_32x32x16_bf16(pa3, PK(l3, h3), od, 0, 0, 0);
#undef PK
}
__device__ __forceinline__ void pv_d0(f32x16* o, int vb, bf16x8 pa0, bf16x8 pa1, bf16x8 pa2, bf16x8 pa3) {
  pv_one<0>(o[0], vb, pa0, pa1, pa2, pa3); pv_one<1>(o[1], vb, pa0, pa1, pa2, pa3); pv_one<2>(o[2], vb, pa0, pa1, pa2, pa3); pv_one<3>(o[3], vb, pa0, pa1, pa2, pa3);
}

__device__ __forceinline__ void attn_unit(const unsigned short* __restrict__ PROJ, unsigned short* __restrict__ BOUT, int b, int h, int qb, float lam, const float* __restrict__ sgw, char* lds) {
  int tid_ = threadIdx.x; asm volatile("" : "+v"(tid_));
  const int tid = tid_, wid = __builtin_amdgcn_readfirstlane(tid >> 6), lane = tid & 63, r32 = lane & 31, hi = lane >> 5;
  const int map = wid >> 2, wq = wid & 3;
  char* V_lds = lds; char* K_lds = lds + 2 * SHM_V;
  float* ws = (float*)(lds + 2 * SHM_V + 2 * SHM_K) + wid * 64; float* li_l = ws; float* al_l = ws + 32;
  float m_reg = -1e30f, l_reg = 0; f32x16 o[4] = {}; bf16x8 qr[4];
  { const int qrow = qb < 32 ? b * SEQ + qb * 128 + wq * 32 + r32 : NX + b * NMETA + (r32 & 15);
    const unsigned short* Qw = PROJ + (size_t)qrow * PW + P_DQ + h * 128 + map * 64 + hi * 8;
#pragma unroll
    for (int d0 = 0; d0 < 4; ++d0) qr[d0] = *reinterpret_cast<const bf16x8*>(Qw + d0 * 16); }
  const int sr = tid >> 4, sc = (tid & 15) * 8, vst0 = v_st(sr, sc), vst1 = v_st(32 + sr, sc);
  const int vb0 = (int)(uintptr_t)V_lds + v_rd_base(lane);
  const int mcolB = map * 128;
  const unsigned short* Kb = PROJ + P_DK + h * 128 + sc; const unsigned short* Vb = PROJ + P_DV + h * 128 + sc;
  struct { bf16x8 vs0, vs1, ks0, ks1; } sr_[2];
#define TROW0(t) ((t) < 64 ? (size_t)(b * SEQ + (t) * 64 + sr) : (size_t)(NX + b * NMETA + (sr & 15)))
#define TROW1(t) ((t) < 64 ? (size_t)(b * SEQ + (t) * 64 + 32 + sr) : (size_t)(NX + b * NMETA + (sr & 15)))
#define SLOAD(i, t) do { const int t_ = (t) < NT ? (t) : NT - 1; const size_t r0_ = TROW0(t_) * PW, r1_ = TROW1(t_) * PW; \
    sr_[i].vs0 = *reinterpret_cast<const bf16x8*>(Vb + r0_); sr_[i].vs1 = *reinterpret_cast<const bf16x8*>(Vb + r1_); \
    sr_[i].ks0 = *reinterpret_cast<const bf16x8*>(Kb + r0_); sr_[i].ks1 = *reinterpret_cast<const bf16x8*>(Kb + r1_); } while (0)
#define SWRITE(bu, i) do { *(bf16x8*)(V_lds + (bu) * SHM_V + vst0) = sr_[i].vs0; *(bf16x8*)(V_lds + (bu) * SHM_V + vst1) = sr_[i].vs1; const int kc = sc * 2; \
    *(bf16x8*)(K_lds + (bu) * SHM_K + KSWZ(sr, kc)) = sr_[i].ks0; *(bf16x8*)(K_lds + (bu) * SHM_K + KSWZ(32 + sr, kc)) = sr_[i].ks1; } while (0)
#define SWAIT() asm volatile("s_waitcnt vmcnt(4)" ::: "memory")
#define RESC(a) do { if (__any((a) < 1.f)) { if (hi == 0) al_l[r32] = (a); asm volatile("s_waitcnt lgkmcnt(0)" ::: "memory"); \
    _Pragma("unroll") for (int d = 0; d < 4; ++d) _Pragma("unroll") for (int r = 0; r < 16; ++r) o[d][r] *= al_l[crow(r, hi)]; } } while (0)
  f32x16 pA0, pA1, pB0, pB1; float mnA, mnB, alA, alB; bf16x8 pa0, pa1, pa2, pa3;
  constexpr int SE = 0, SO = 1;
  SLOAD(SE, 0); asm volatile("s_waitcnt vmcnt(0)" ::: "memory"); SWRITE(0, SE); __syncthreads();
  qkt(pA0, pA1, K_lds, qr, r32, hi, mcolB); partialSM(pA0, pA1, m_reg, mnA, alA);
  SLOAD(SO, 1); SLOAD(SE, 2);
  SWAIT(); SWRITE(1, SO); __syncthreads();
  for (int j = 1; j + 1 < NT; j += 2) {
    SBAR(); qkt(pB0, pB1, K_lds + SHM_K, qr, r32, hi, mcolB);
    finishSM(pA0, pA1, alA, l_reg, pa0, pa1, pa2, pa3); SBAR();
    SLOAD(SO, j + 2); SBAR();
    pv_d0(o, vb0, pa0, pa1, pa2, pa3); partialSM(pB0, pB1, m_reg, mnB, alB);
    __syncthreads(); SWAIT(); SWRITE(0, SE);
    RESC(alB); __syncthreads();
    SBAR(); qkt(pA0, pA1, K_lds, qr, r32, hi, mcolB);
    if (j + 1 == NT - 1) {
#pragma unroll
      for (int r = 8; r < 16; ++r) pA0[r] = -INFINITY;
#pragma unroll
      for (int r = 0; r < 16; ++r) pA1[r] = -INFINITY;
    }
    finishSM(pB0, pB1, alB, l_reg, pa0, pa1, pa2, pa3); SBAR();
    SLOAD(SE, j + 3); SBAR();
    pv_d0(o, vb0 + SHM_V, pa0, pa1, pa2, pa3); partialSM(pA0, pA1, m_reg, mnA, alA);
    __syncthreads(); SWAIT(); SWRITE(1, SO);
    RESC(alA); __syncthreads();
  }
  finishSM(pA0, pA1, alA, l_reg, pa0, pa1, pa2, pa3); SBAR();
  pv_d0(o, vb0, pa0, pa1, pa2, pa3);
  asm volatile("s_waitcnt vmcnt(0)" ::: "memory");
  if (hi == 0) li_l[r32] = l_reg; asm volatile("s_waitcnt lgkmcnt(0)" ::: "memory");
  float rli[16];
#pragma unroll
  for (int r = 0; r < 16; ++r) rli[r] = 1.0f / li_l[crow(r, hi)];
#pragma unroll
  for (int d = 0; d < 4; ++d)
#pragma unroll
    for (int r = 0; r < 16; ++r) o[d][r] *= rli[r];
  __syncthreads();
  float* xch = (float*)lds + wq * 4096;
  if (map == 1) {
#pragma unroll
    for (int d = 0; d < 4; ++d)
#pragma unroll
      for (int r = 0; r < 16; ++r) xch[(d * 16 + r) * 64 + lane] = o[d][r];
  }
  __syncthreads();
  if (map == 0) {
    float ss[16];
#pragma unroll
    for (int r = 0; r < 16; ++r) ss[r] = 0.f;
#pragma unroll
    for (int d = 0; d < 4; ++d)
#pragma unroll
      for (int r = 0; r < 16; ++r) { const float v = o[d][r] - lam * xch[(d * 16 + r) * 64 + lane]; o[d][r] = v; ss[r] += v * v; }
#pragma unroll
    for (int r = 0; r < 16; ++r) { float s = ss[r]; s += __shfl_xor(s, 1); s += __shfl_xor(s, 2); s += __shfl_xor(s, 4); s += __shfl_xor(s, 8); s += __shfl_xor(s, 16); ss[r] = rsqrtf(s * (1.f / 128.f) + EPS) * 0.8f; }
    float g[4];
#pragma unroll
    for (int d = 0; d < 4; ++d) g[d] = sgw[d * 32 + r32];
#pragma unroll
    for (int r = 0; r < 16; ++r) { const int qi = crow(r, hi);
      if (qb < 32 || (wq == 0 && qi < 16)) {
        const size_t orow = qb < 32 ? (size_t)(b * SEQ + qb * 128 + wq * 32 + qi) : (size_t)(NX + b * NMETA + qi);
        unsigned short* op = BOUT + orow * 1024 + h * 128 + r32;
#pragma unroll
        for (int d = 0; d < 4; ++d) op[d * 32] = (unsigned short)f2bf((o[d][r] * ss[r]) * g[d]);
      } }
  }
  __syncthreads();
#undef TROW0
#undef TROW1
#undef SLOAD
#undef SWRITE
#undef SWAIT
#undef RESC
}
#undef KSWZ
#undef SBAR
}

namespace mls {
using bf16x8 = __attribute__((ext_vector_type(8))) short;
using s16x4  = __attribute__((ext_vector_type(4))) short;
using f32x4v = __attribute__((ext_vector_type(4))) float;
using f32x16 = __attribute__((ext_vector_type(16))) float;
constexpr int RS = 528;
constexpr int QS = 0, CB = 33792, KI = 67584, VT = 100352, VTW = 109568, ST = 118784, SC = 128000;
constexpr int S_U = 0, S_PM = 64, S_A = 128, S_EM = 192, S_W = 256, S_D1 = 320, S_D2 = 384, S_N = 448, S_MISC = 704;
constexpr int CWL = 132096;
static_assert(SC + 2880 <= 131072, "mLSTM LDS map");
__device__ __forceinline__ int kimg_row(int k) { const int kk = (k & ~0xC) | ((k & 4) << 1) | ((k & 8) >> 1); return (kk >> 3) * 2048 + (kk & 7) * 64; }
constexpr int kimg_rowc(int k) { return ((((k & ~0xC) | ((k & 4) << 1) | ((k & 8) >> 1)) >> 3) * 2048) + ((((k & ~0xC) | ((k & 4) << 1) | ((k & 8) >> 1)) & 7) * 64); }
__device__ __forceinline__ int kimg_col(int c) { return (c >> 7) * 16384 + ((c & 127) >> 5) * 512 + (c & 31) * 2; }
__device__ __forceinline__ int v_rd_base(int lane) { return ((lane & 3) << 3) | (((lane >> 2) & 3) << 6) | (((lane >> 4) & 1) << 5) | (((lane >> 5) & 1) << 8); }
template <int OFF> __device__ __forceinline__ s16x4 tr_read(int vb) { s16x4 r; asm volatile("ds_read_b64_tr_b16 %0, %1 offset:%2" : "=&v"(r) : "v"(vb), "i"(OFF) : "memory"); return r; }
__device__ __forceinline__ float bfs(short v) { return __builtin_bit_cast(float, ((unsigned)(unsigned short)v) << 16); }
#define LD8(p) (*(const bf16x8*)(p))

template <int DIR>
__device__ __forceinline__ void mlstm_unit(const unsigned short* __restrict__ PROJ, const float* __restrict__ GATES, const float* __restrict__ gbias, const float* __restrict__ cw,
                                           unsigned short* __restrict__ HOUT, int b, int head, int vs, char* lds) {
  int tid_ = threadIdx.x; asm volatile("" : "+v"(tid_));
  const int tid = tid_, wid = __builtin_amdgcn_readfirstlane(tid >> 6), lane = tid & 63, fr = lane & 15, g4 = lane >> 4, r32 = lane & 31, hi = lane >> 5;
  float* scal = (float*)(lds + SC);
  const int cg = tid & 63, rg = tid >> 6;
  const int ccol = cg < 32 ? head * 256 + cg * 8 : 1024 + head * 256 + (cg - 32) * 8;
  const float ksc = cg < 32 ? 1.f : 0.0625f;
  float* cwl = (float*)(lds + CWL);
  const int vi = tid >> 3, vcg = tid & 7;
  const float bi = gbias[DIR * 8 + head], bfg = gbias[DIR * 8 + 4 + head];
  const int tb = wid >> 1, wlo = wid & 1;
  for (int i = tid; i < 3 * 512; i += 512) { const int j = i & 511, t3 = i >> 9; cwl[i] = cw[t3 * 2048 + (j < 256 ? head * 256 + j : 1024 + head * 256 + (j - 256))]; }
  for (int i = tid; i < 33792 / 16; i += 512) *(f32x4v*)(lds + CB + i * 16) = (f32x4v){0.f, 0.f, 0.f, 0.f};
  if (tid < 256) scal[S_N + tid] = 0.f;
  f32x16 X0 = f32x16{}, X1 = f32x16{};
  float m_prev = 0.f;
  bf16x8 rq[10]; bf16x8 rv; float gri = 0.f, grf = 0.f; bool gok = false;
  const bf16x8 zero8 = {0, 0, 0, 0, 0, 0, 0, 0};
#define PREFETCH(c_) do { const int p0_ = 64 * (c_) - 48 + 8 * rg; \
    _Pragma("unroll") for (int j = 0; j < 10; ++j) { const int p_ = p0_ - 1 + j; rq[j] = (p_ >= 0 && p_ < L) ? *reinterpret_cast<const bf16x8*>(PROJ + (size_t)rowof(b, p_) * PW + P_MQK + ccol) : zero8; } \
    { const int p_ = 64 * (c_) - 48 + vi; rv = (p_ >= 0 && p_ < L) ? *reinterpret_cast<const bf16x8*>(PROJ + (size_t)rowof(b, p_) * PW + P_MV + head * 256 + vs * 64 + vcg * 8) : zero8; } \
    if (tid < 64) { const int i_ = DIR ? 63 - tid : tid; const int p_ = 64 * (c_) - 48 + i_; \
      gok = (p_ >= 0 && p_ < L); if (gok) { const float* gr = GATES + (size_t)rowof(b, p_) * 16 + DIR * 8 + head; gri = gr[0]; grf = gr[4]; } } } while (0)
  PREFETCH(DIR ? 64 : 0);
  __syncthreads();
  for (int ci = 0; ci < 65; ++ci) {
    const int c = DIR ? 64 - ci : ci;
    if (wid == 0) {
      const float gli = gok ? gri + bi : -30.f, glf = gok ? logsigmoidf_(grf + bfg) : 0.f;
      float bcs = glf;
#pragma unroll
      for (int o = 1; o < 64; o <<= 1) { const float t = __shfl_up(bcs, o); if (lane >= o) bcs += t; }
      const float u = gli - bcs; float cm = u;
#pragma unroll
      for (int o = 1; o < 64; o <<= 1) { const float t = __shfl_up(cm, o); if (lane >= o) cm = fmaxf(cm, t); }
      const float pm = fmaxf(m_prev, cm);
      const float pm63 = __shfl(pm, 63), g = __shfl(bcs, 63);
      scal[S_U + lane] = u; scal[S_PM + lane] = pm; scal[S_A + lane] = __expf(m_prev - pm); scal[S_EM + lane] = __expf(-(bcs + pm)); scal[S_W + lane] = __expf(u - pm63);
      if (lane == 0) scal[S_MISC] = __expf(m_prev - pm63);
      m_prev = g + pm63;
    }
    {
      const int p0 = 64 * c - 48 + 8 * rg;
      float xa[8], xb[8], xc[8], w0[8], w1[8], w2[8];
      { const f32x4v* wp = (const f32x4v*)(cwl + cg * 8);
        const f32x4v a0 = wp[0], a1 = wp[1], b0 = wp[128], b1 = wp[129], c0 = wp[256], c1 = wp[257];
#pragma unroll
        for (int e = 0; e < 4; ++e) { w0[e] = a0[e]; w0[4 + e] = a1[e]; w1[e] = b0[e]; w1[4 + e] = b1[e]; w2[e] = c0[e]; w2[4 + e] = c1[e]; } }
      char* wq = lds + QS + (DIR ? 63 - 8 * rg : 8 * rg) * RS + cg * 16;
      char* wk = lds + KI + kimg_row(DIR ? 56 - 8 * rg : 8 * rg) + kimg_col((cg & 31) * 8);
#pragma unroll
      for (int e = 0; e < 8; ++e) { xa[e] = bfs(rq[0][e]); xb[e] = bfs(rq[1][e]); }
#pragma unroll
      for (int j = 0; j < 8; ++j) {
#pragma unroll
        for (int e = 0; e < 8; ++e) xc[e] = bfs(rq[j + 2][e]);
        const int p = p0 + j; const bool ok = (p >= 0 && p < L);
        unsigned pk[4];
#pragma unroll
        for (int e = 0; e < 8; e += 2) { float y0 = siluf_(xa[e] * w0[e] + xb[e] * w1[e] + xc[e] * w2[e]) * ksc, y1 = siluf_(xa[e + 1] * w0[e + 1] + xb[e + 1] * w1[e + 1] + xc[e + 1] * w2[e + 1]) * ksc;
          pk[e >> 1] = ok ? pk2(y0, y1) : 0u; }
        const int jt = DIR ? 7 - j : j;
        if (cg < 32) *(v4u*)(wq + (DIR ? -j : j) * RS) = (v4u){pk[0], pk[1], pk[2], pk[3]};
        else *(v4u*)(wk + kimg_rowc(jt)) = (v4u){pk[0], pk[1], pk[2], pk[3]};
#pragma unroll
        for (int e = 0; e < 8; ++e) { xa[e] = xb[e]; xb[e] = xc[e]; }
      }
    }
    const bf16x8 vcur = rv;
    __syncthreads();
    if (ci + 1 < 65) PREFETCH(DIR ? 63 - ci : ci + 1);
    { const int tau = DIR ? 63 - vi : vi; const float wt = scal[S_W + tau];
      char* pv = lds + VT + vcg * 8 * 144 + tau * 2;
#pragma unroll
      for (int e = 0; e < 8; ++e) { const float v = bfs(vcur[e]);
        *(unsigned short*)(pv + e * 144) = (unsigned short)vcur[e];
        *(unsigned short*)(pv + (VTW - VT) + e * 144) = (unsigned short)f2bf(v * wt); } }
    { const int t = tid >> 3, j = tid & 7; float s = 0.f; const char* qp = lds + QS + t * RS + 64 * j; const float* np = scal + S_N + 32 * j;
#pragma unroll
      for (int q = 0; q < 4; ++q) { const bf16x8 qv = LD8(qp + 16 * q);
        const f32x4v n0 = *(const f32x4v*)(np + 8 * q), n1 = *(const f32x4v*)(np + 8 * q + 4);
        s += bfs(qv[0]) * n0[0] + bfs(qv[1]) * n0[1] + bfs(qv[2]) * n0[2] + bfs(qv[3]) * n0[3] + bfs(qv[4]) * n1[0] + bfs(qv[5]) * n1[1] + bfs(qv[6]) * n1[2] + bfs(qv[7]) * n1[3]; }
      s += __shfl_xor(s, 1); s += __shfl_xor(s, 2); s += __shfl_xor(s, 4);
      if (j == 0) scal[S_D2 + t] = s; }
    const char* qfp = lds + QS + (16 * tb + fr) * RS + 16 * g4;
    {
      bf16x8 qf[8];
#pragma unroll
      for (int ks = 0; ks < 8; ++ks) qf[ks] = LD8(qfp + 64 * ks);
      const char* kp = lds + KI + kimg_row(32 * wlo + fr) + 16 * g4;
      char* sp = lds + ST + (16 * tb + 4 * g4) * 144 + (32 * wlo + fr) * 2;
      const float* pmp = scal + S_PM + 16 * tb + 4 * g4;
#pragma unroll
      for (int i2 = 0; i2 < 2; ++i2) {
        const int sb = 2 * wlo + i2;
        f32x4v acc = {0.f, 0.f, 0.f, 0.f};
        if (sb <= tb) {
#pragma unroll
          for (int ks = 0; ks < 8; ++ks) acc = __builtin_amdgcn_mfma_f32_16x16x32_bf16(qf[ks], LD8(kp + 4096 * i2 + (ks & 3) * 512 + (ks >> 2) * 16384), acc, 0, 0, 0);
        }
        const int s = 16 * sb + fr; const float us = scal[S_U + s];
#pragma unroll
        for (int r = 0; r < 4; ++r) { const int t = 16 * tb + 4 * g4 + r;
          const float v = (s <= t) ? acc[r] * __expf(us - pmp[r]) : 0.f;
          *(unsigned short*)(sp + 144 * r + 32 * i2) = (unsigned short)f2bf(v); }
      }
    }
    __syncthreads();
    if (tid < 64) { float s = 0.f; const char* rp = lds + ST + tid * 144;
#pragma unroll
      for (int q = 0; q < 8; ++q) { const bf16x8 sv = LD8(rp + q * 16);
#pragma unroll
        for (int e = 0; e < 8; ++e) s += bfs(sv[e]); }
      scal[S_D1 + tid] = s; }
    f32x4v y1[2], y2[2];
    {
      const char* sap = lds + ST + (16 * tb + fr) * 144 + 16 * g4;
      const char* vtp = lds + VT + (32 * wlo + fr) * 144 + 16 * g4;
      const char* cbp = lds + CB + (32 * wlo + fr) * RS + 16 * g4;
#pragma unroll
      for (int i2 = 0; i2 < 2; ++i2) {
        y1[i2] = (f32x4v){0.f, 0.f, 0.f, 0.f}; y2[i2] = (f32x4v){0.f, 0.f, 0.f, 0.f};
#pragma unroll
        for (int ks = 0; ks < 2; ++ks) y1[i2] = __builtin_amdgcn_mfma_f32_16x16x32_bf16(LD8(sap + 64 * ks), LD8(vtp + 16 * 144 * i2 + 64 * ks), y1[i2], 0, 0, 0);
#pragma unroll
        for (int ks = 0; ks < 8; ++ks) y2[i2] = __builtin_amdgcn_mfma_f32_16x16x32_bf16(LD8(qfp + 64 * ks), LD8(cbp + 16 * RS * i2 + 64 * ks), y2[i2], 0, 0, 0);
      }
    }
    { const float decay = scal[S_MISC];
#pragma unroll
      for (int r = 0; r < 16; ++r) { X0[r] *= decay; X1[r] *= decay; }
      const int vbk = (int)(uintptr_t)(lds + KI) + (wid >> 2) * 16384 + (wid & 3) * 512 + v_rd_base(lane);
      const s16x4 l0 = tr_read<0>(vbk), h0 = tr_read<2048>(vbk), l1 = tr_read<4096>(vbk), h1 = tr_read<4096 + 2048>(vbk);
      const s16x4 l2 = tr_read<8192>(vbk), h2 = tr_read<8192 + 2048>(vbk), l3 = tr_read<12288>(vbk), h3 = tr_read<12288 + 2048>(vbk);
      asm volatile("s_waitcnt lgkmcnt(0)" ::: "memory"); __builtin_amdgcn_sched_barrier(0);
#define PK(L_, H_) (bf16x8){L_[0], L_[1], L_[2], L_[3], H_[0], H_[1], H_[2], H_[3]}
      const bf16x8 kb0 = PK(l0, h0), kb1 = PK(l1, h1), kb2 = PK(l2, h2), kb3 = PK(l3, h3);
#undef PK
      const char* ap = lds + VTW + r32 * 144 + hi * 16;
      X0 = __builtin_amdgcn_mfma_f32_32x32x16_bf16(LD8(ap), kb0, X0, 0, 0, 0);
      X0 = __builtin_amdgcn_mfma_f32_32x32x16_bf16(LD8(ap + 32), kb1, X0, 0, 0, 0);
      X0 = __builtin_amdgcn_mfma_f32_32x32x16_bf16(LD8(ap + 64), kb2, X0, 0, 0, 0);
      X0 = __builtin_amdgcn_mfma_f32_32x32x16_bf16(LD8(ap + 96), kb3, X0, 0, 0, 0);
      X1 = __builtin_amdgcn_mfma_f32_32x32x16_bf16(LD8(ap + 32 * 144), kb0, X1, 0, 0, 0);
      X1 = __builtin_amdgcn_mfma_f32_32x32x16_bf16(LD8(ap + 32 * 144 + 32), kb1, X1, 0, 0, 0);
      X1 = __builtin_amdgcn_mfma_f32_32x32x16_bf16(LD8(ap + 32 * 144 + 64), kb2, X1, 0, 0, 0);
      X1 = __builtin_amdgcn_mfma_f32_32x32x16_bf16(LD8(ap + 32 * 144 + 96), kb3, X1, 0, 0, 0);
    }
    __syncthreads();
    { const float* ap = scal + S_A + 16 * tb + 4 * g4;
#pragma unroll
      for (int r = 0; r < 4; ++r) { const int t = 16 * tb + 4 * g4 + r; const float a = ap[r];
        const float inv = 1.0f / fmaxf(fabsf(ap[(S_D1 - S_A) + r] + a * ap[(S_D2 - S_A) + r]), ap[(S_EM - S_A) + r]);
        const int i = DIR ? 63 - t : t; const int p = 64 * c - 48 + i;
        if (p >= 0 && p < L) { unsigned short* op = HOUT + (size_t)rowof(b, p) * 1024 + head * 256 + vs * 64 + 32 * wlo + fr;
          op[0] = (unsigned short)f2bf((y1[0][r] + a * y2[0][r]) * inv); op[16] = (unsigned short)f2bf((y1[1][r] + a * y2[1][r]) * inv); } }
    }
    { char* cwp = lds + CB + 4 * hi * RS + (32 * wid + r32) * 2;
#pragma unroll
      for (int r = 0; r < 16; ++r) { *(unsigned short*)(cwp + ((r & 3) + 8 * (r >> 2)) * RS) = (unsigned short)f2bf(X0[r]); *(unsigned short*)(cwp + (32 + (r & 3) + 8 * (r >> 2)) * RS) = (unsigned short)f2bf(X1[r]); } }
    { const int d = tid >> 1, hf = tid & 1; float s = 0.f; const char* kp = lds + KI + kimg_col(d) + 8192 * hf; const float* wp = scal + S_W + 32 * hf;
#pragma unroll
      for (int q = 0; q < 32; ++q) s += wp[q] * bf2f(*(const unsigned short*)(kp + kimg_rowc(q)));
      s += __shfl_xor(s, 1);
      if (hf == 0) scal[S_N + d] = scal[S_MISC] * scal[S_N + d] + s; }
    __syncthreads();
  }
#undef PREFETCH
}
#undef LD8
}

__device__ __forceinline__ void transpose_item(const float* W, int ldw, int K, int ncols, bf16* WT, int row_off, LAS float* scr, int item, int lane) {
    const int nblk = ncols / 32, kb = item / nblk, nb = item % nblk, k0 = 64 * kb, n0 = 32 * nb;
#pragma unroll 8
    for (int i = 0; i < 32; ++i) { const int kk = 2 * i + (lane >> 5); scr[kk * 33 + (lane & 31)] = W[(size_t)(k0 + kk) * ldw + n0 + (lane & 31)]; }
    LDS_WAIT(); asm volatile("" ::: "memory");
    const int c = lane & 7;
#pragma unroll
    for (int j = 0; j < 4; ++j) { const int n = (lane >> 3) + 8 * j; const LAS float* s = scr + (8 * c) * 33 + n;
        v4u o; o.x = pk2(s[0 * 33], s[1 * 33]); o.y = pk2(s[2 * 33], s[3 * 33]); o.z = pk2(s[4 * 33], s[5 * 33]); o.w = pk2(s[6 * 33], s[7 * 33]);
        *(GAS v4u*)(WT + (size_t)(row_off + n0 + n) * K + k0 + 8 * c) = o; }
    LDS_WAIT(); asm volatile("" ::: "memory");
}

struct Args { const float* in[20]; float* out; unsigned char* ws; int ph_lo, ph_hi; };
enum { I_X = 0, I_META, I_G1, I_WIN, I_MCONV, I_GBIAS, I_MNG, I_LQ1, I_LK1, I_LQ2, I_LK2, I_SG, I_WA, I_WB, I_WOUT, I_G2, I_WUP, I_FCONV, I_WDOWN, I_GF };
constexpr int N_PHASES = 10;
#ifndef MK_ONE_LAUNCH
#define MK_ONE_LAUNCH 1
#endif

__global__ void __launch_bounds__(NWAVES * 64, 2) mk_fwd(Args args) {
    extern __shared__ __attribute__((aligned(16))) unsigned char lds_raw[];
    LAS unsigned char* lds = (LAS unsigned char*)lds_raw;
    volatile LAS unsigned* MISC = (volatile LAS unsigned*)(lds + MISC_OFF);
    const int tid = threadIdx.x, lane = tid & 63, wave = __builtin_amdgcn_readfirstlane(tid >> 6);
    const int G = gridDim.x; const int bx = blockIdx.x; const int vcu = (G % 8 == 0) ? (bx % 8) * (G / 8) + bx / 8 : bx;
    unsigned char* ws = args.ws;
    gu32* ctl = (gu32*)(ws + WS_CTL);
    for (int u = tid; u < (LDS_BYTES - LDSCTL_OFF) / 4; u += NWAVES * 64) ((LAS unsigned*)(lds + LDSCTL_OFF))[u] = 0u;
    __syncthreads();
    XcdBarrier bar; bar.bar = (unsigned*)(ctl + CW_BAR); bar.x = 0; bar.st = nullptr;
    if (MK_ONE_LAUNCH) bar = xcd_barrier_post((unsigned*)(ctl + CW_BAR), MISC + 8);
    const int lo = args.ph_lo, hi = args.ph_hi;
#define IN(k) (lo <= (k) && (k) < hi)
#define SEAM(k) do { if (IN(k) && IN((k) + 1)) xcd_barrier(bar); } while (0)
    const float* x = args.in[I_X]; const float* meta = args.in[I_META];
    bf16* WT_IN = (bf16*)(ws + WS_W1); bf16* WT_UP = (bf16*)(ws + WS_W1); bf16* WT_A = (bf16*)(ws + WS_WA); bf16* WT_B = (bf16*)(ws + WS_WB); bf16* WT_OUT = (bf16*)(ws + WS_WOUT); bf16* WT_DOWN = (bf16*)(ws + WS_WDOWN);
    bf16* A1 = (bf16*)(ws + WS_A); bf16* AOUT = (bf16*)(ws + WS_A); bf16* BOUT = AOUT + (size_t)MP * 1024; bf16* A2 = (bf16*)(ws + WS_A);
    bf16* MERGED = (bf16*)(ws + WS_X); bf16* HF = (bf16*)(ws + WS_X); bf16* HB = HF + (size_t)MP * 1024; bf16* PROJ = (bf16*)(ws + WS_P); bf16* UP = (bf16*)(ws + WS_P); bf16* ACT = (bf16*)(ws + WS_ACT);
    float* GATES = (float*)(ws + WS_GATES); float* R1 = (float*)(ws + WS_R1); float* ROPE = (float*)(ws + WS_ROPE);
    float* SS2 = (float*)(ws + WS_CTL) + CW_SS2; float* SS3 = (float*)(ws + WS_CTL) + CW_SS3;
    const int gw = vcu * NWAVES + wave, NGW = G * NWAVES;
    LAS float* scr = (LAS float*)(lds + RING_OFF + wave * 16384);

    if (IN(0)) {
        const float* w_in = args.in[I_WIN];
        constexpr int I0 = 32 * (4096 / 32), I1 = 32 * (7168 / 32), IA = 16 * 64, IO = 32 * 64, ID = 88 * 64;
        constexpr int NITEMS = I0 + I1 + 2 * IA + IO + ID;
        for (int it = gw; it < NITEMS; it += NGW) {
            int r = it;
            if (r < I0) { transpose_item(w_in, INW, D, 4096, WT_IN, 0, scr, r, lane); continue; } r -= I0;
            if (r < I1) { transpose_item(w_in + 4112, INW, D, 7168, WT_IN, 4096, scr, r, lane); continue; } r -= I1;
            if (r < IA) { transpose_item(args.in[I_WA], D, 1024, 2048, WT_A, 0, scr, r, lane); continue; } r -= IA;
            if (r < IA) { transpose_item(args.in[I_WB], D, 1024, 2048, WT_B, 0, scr, r, lane); continue; } r -= IA;
            if (r < IO) { transpose_item(args.in[I_WOUT], D, D, 2048, WT_OUT, 0, scr, r, lane); continue; } r -= IO;
            transpose_item(args.in[I_WDOWN], D, FFN, 2048, WT_DOWN, 0, scr, r, lane);
        }
        const float* g1 = args.in[I_G1];
        for (int row = gw; row < MP; row += NGW) {
            GAS v2u* ao = (GAS v2u*)(A1 + (size_t)row * D) + lane;
            if (row >= NR) { for (int j = 0; j < 8; ++j) ao[64 * j] = (v2u){0u, 0u}; if (lane == 0) R1[row] = 0.f; continue; }
            const float* hr = row < NX ? x + (size_t)row * D : meta + (size_t)((row - NX) & 15) * D;
            f32x4 v[8]; float s = 0.f;
#pragma unroll
            for (int j = 0; j < 8; ++j) { v[j] = *(const f32x4*)(hr + 4 * lane + 256 * j); s += (v[j][0] * v[j][0] + v[j][1] * v[j][1]) + (v[j][2] * v[j][2] + v[j][3] * v[j][3]); }
            const float r = rsqrtf(wave_sum(s) * (1.f / D) + EPS);
            float ga[16];
#pragma unroll
            for (int q = 0; q < 16; ++q) ga[q] = 0.f;
#pragma unroll
            for (int j = 0; j < 8; ++j) {
                const f32x4 a = v[j] * *(const f32x4*)(g1 + 4 * lane + 256 * j);
                ao[64 * j] = (v2u){pk2(a[0], a[1]), pk2(a[2], a[3])};
#pragma unroll
                for (int e = 0; e < 4; ++e) { const f32x4* wg = (const f32x4*)(w_in + (size_t)(4 * lane + 256 * j + e) * INW + C_G);
#pragma unroll
                    for (int q = 0; q < 4; ++q) { const f32x4 wv = wg[q]; ga[4 * q] += a[e] * wv[0]; ga[4 * q + 1] += a[e] * wv[1]; ga[4 * q + 2] += a[e] * wv[2]; ga[4 * q + 3] += a[e] * wv[3]; } }
            }
#pragma unroll
            for (int q = 0; q < 16; ++q) ga[q] = wave_sum(ga[q]);
            if (lane == 0) { R1[row] = r;
#pragma unroll
                for (int q = 0; q < 16; ++q) GATES[(size_t)row * 16 + q] = ga[q] * r; }
        }
        for (int i = (vcu * NWAVES * 64) + tid; i < L * 8; i += G * NWAVES * 64) { const int p = i >> 3, j = i & 7;
            const float ang = (float)p * powf(500000.f, -(float)j / 8.f); ROPE[(size_t)p * 16 + 2 * j] = cosf(ang); ROPE[(size_t)p * 16 + 2 * j + 1] = sinf(ang); }
    }
    SEAM(0);
    if (IN(1)) {
        pg8::Gemm g{A1, WT_IN, MP, PW, D, A1, WT_IN}; pg8::StaticOrder S; S.init(MP, PW, G, bx);
        pg8::EpiProj E{PROJ, R1, ROPE};
        pg8::gemm_phase<pg8::EpiProj, pg8::StaticOrder, true, true>(lds + RING_OFF, g, S, E);
    }
    SEAM(1);
    if (IN(2)) {
        constexpr int IU = 32 * (PW / 32);
        for (int it = gw; it < IU; it += NGW) transpose_item(args.in[I_WUP], PW, D, PW, WT_UP, 0, scr, it, lane);
        __syncthreads();
        const float lam = expf(wave_sum(args.in[I_LQ1][lane] * args.in[I_LK1][lane])) - expf(wave_sum(args.in[I_LQ2][lane] * args.in[I_LK2][lane])) + 0.2f;
        for (;;) {
            if (tid == 0) MISC[16] = __hip_atomic_fetch_add(ctl + CW_WQ, 1u, RLX_AGENT);
            __syncthreads();
            const int u = (int)MISC[16];
            __syncthreads();
            if (u >= 64 + 16 * 33) break;
            if (u < 64) { if ((u >> 2) & 1) mls::mlstm_unit<1>(PROJ, GATES, args.in[I_GBIAS], args.in[I_MCONV], HB, u >> 5, (u >> 3) & 3, u & 3, (char*)lds_raw);
                          else mls::mlstm_unit<0>(PROJ, GATES, args.in[I_GBIAS], args.in[I_MCONV], HF, u >> 5, (u >> 3) & 3, u & 3, (char*)lds_raw); }
            else { const int ua = u - 64; const int qb = ua / 16, bh = ua % 16;
                att::attn_unit(PROJ, BOUT, bh >> 3, bh & 7, qb, lam, args.in[I_SG], (char*)lds_raw); }
        }
    }
    SEAM(2);
    if (IN(3)) {
        const float* ng = args.in[I_MNG];
        for (int it = gw; it < NR * MH; it += NGW) {
            const int row = it >> 2, head = it & 3; const size_t o = (size_t)row * 1024 + head * 256 + 4 * lane;
            const v2u a = *(const v2u*)(HF + o), c = *(const v2u*)(HB + o), mo = *(const v2u*)(PROJ + (size_t)row * PW + P_MO + head * 256 + 4 * lane);
            float h0 = bflo(a.x) + bflo(c.x), h1 = bfhi(a.x) + bfhi(c.x), h2 = bflo(a.y) + bflo(c.y), h3 = bfhi(a.y) + bfhi(c.y);
            const float mu = wave_sum((h0 + h1) + (h2 + h3)) * (1.f / 256.f);
            h0 -= mu; h1 -= mu; h2 -= mu; h3 -= mu;
            const float rs = rsqrtf(wave_sum((h0 * h0 + h1 * h1) + (h2 * h2 + h3 * h3)) * (1.f / 256.f) + EPS);
            const f32x4 gv = *(const f32x4*)(ng + head * 256 + 4 * lane);
            const float o0 = sigmoidf_(bflo(mo.x)) * ((h0 * rs) * gv[0]), o1 = sigmoidf_(bfhi(mo.x)) * ((h1 * rs) * gv[1]), o2 = sigmoidf_(bflo(mo.y)) * ((h2 * rs) * gv[2]), o3 = sigmoidf_(bfhi(mo.y)) * ((h3 * rs) * gv[3]);
            *(v2u*)(AOUT + o) = (v2u){pk2(o0, o1), pk2(o2, o3)};
        }
    }
    SEAM(3);
    if (IN(4)) {
        pg8::Gemm g{AOUT, WT_A, MP, D, 1024, BOUT, WT_B}; pg8::PairOrder S; S.S.init(MP, D, G, bx);
        pg8::EpiMerged E{PROJ, MERGED};
        pg8::gemm_phase<pg8::EpiMerged, pg8::PairOrder, false, true>(lds + RING_OFF, g, S, E);
    }
    SEAM(4);
    if (IN(5)) {
        pg8::Gemm g{MERGED, WT_OUT, MP, D, D, MERGED, WT_OUT}; pg8::StaticOrder S; S.init(MP, D, G, bx);
        pg8::EpiOut E{x, meta, args.in[I_G2], args.out, A2, SS2};
        pg8::gemm_phase<pg8::EpiOut, pg8::StaticOrder, true, true>(lds + RING_OFF, g, S, E);
    }
    SEAM(5);
    if (IN(6)) {
        pg8::Gemm g{A2, WT_UP, MP, PW, D, A2, WT_UP}; pg8::StaticOrder S; S.init(MP, PW, G, bx);
        pg8::EpiUp E{UP, SS2};
        pg8::gemm_phase<pg8::EpiUp, pg8::StaticOrder, true, true>(lds + RING_OFF, g, S, E);
    }
    SEAM(6);
    if (IN(7)) {
        const float* fw = args.in[I_FCONV];
        const int gt = vcu * (NWAVES * 64) + tid, NGT = G * NWAVES * 64;
        for (int it = gt; it < 128 * 704; it += NGT) {
            const int cgp = it % 704, seg = it / 704; const int c0 = cgp * 8; const int b = seg >> 6, s0 = (seg & 63) * 64;
            float wg[3][8], wv[3][8];
#pragma unroll
            for (int t3 = 0; t3 < 3; ++t3) { const f32x4 g0 = *(const f32x4*)(fw + (size_t)t3 * 2 * FFN + c0), g1_ = *(const f32x4*)(fw + (size_t)t3 * 2 * FFN + c0 + 4), v0 = *(const f32x4*)(fw + (size_t)t3 * 2 * FFN + FFN + c0), v1 = *(const f32x4*)(fw + (size_t)t3 * 2 * FFN + FFN + c0 + 4);
#pragma unroll
                for (int e = 0; e < 4; ++e) { wg[t3][e] = g0[e]; wg[t3][4 + e] = g1_[e]; wv[t3][e] = v0[e]; wv[t3][4 + e] = v1[e]; } }
            const size_t rprev = s0 > 0 ? (size_t)(b * SEQ + s0 - 1) : (size_t)(NX + b * NMETA + 15);
            v4u ga = *(const v4u*)(UP + rprev * PW + c0), va = *(const v4u*)(UP + rprev * PW + FFN + c0);
            v4u gb = *(const v4u*)(UP + (size_t)(b * SEQ + s0) * PW + c0), vb = *(const v4u*)(UP + (size_t)(b * SEQ + s0) * PW + FFN + c0);
            for (int s = s0; s < s0 + 64; ++s) {
                v4u gc = (v4u){0u, 0u, 0u, 0u}, vc = (v4u){0u, 0u, 0u, 0u};
                if (s + 1 < SEQ) { gc = *(const v4u*)(UP + (size_t)(b * SEQ + s + 1) * PW + c0); vc = *(const v4u*)(UP + (size_t)(b * SEQ + s + 1) * PW + FFN + c0); }
                unsigned ow[4];
#pragma unroll
                for (int q = 0; q < 4; ++q) {
                    const float cg0 = bflo(ga[q]) * wg[0][2 * q] + bflo(gb[q]) * wg[1][2 * q] + bflo(gc[q]) * wg[2][2 * q], cg1 = bfhi(ga[q]) * wg[0][2 * q + 1] + bfhi(gb[q]) * wg[1][2 * q + 1] + bfhi(gc[q]) * wg[2][2 * q + 1];
                    const float cv0 = bflo(va[q]) * wv[0][2 * q] + bflo(vb[q]) * wv[1][2 * q] + bflo(vc[q]) * wv[2][2 * q], cv1 = bfhi(va[q]) * wv[0][2 * q + 1] + bfhi(vb[q]) * wv[1][2 * q + 1] + bfhi(vc[q]) * wv[2][2 * q + 1];
                    ow[q] = pk2(siluf_(cg0) * cv0, siluf_(cg1) * cv1);
                }
                *(v4u*)(ACT + (size_t)(b * SEQ + s) * FFN + c0) = (v4u){ow[0], ow[1], ow[2], ow[3]};
                ga = gb; gb = gc; va = vb; vb = vc;
            }
        }
    }
    SEAM(7);
    if (IN(8)) {
        pg8::Gemm g{ACT, WT_DOWN, NX, D, FFN, ACT, WT_DOWN}; pg8::StaticOrder S; S.init(NX, D, G, bx);
        pg8::EpiDown E{args.out, SS3};
        pg8::gemm_phase<pg8::EpiDown, pg8::StaticOrder, true, true>(lds + RING_OFF, g, S, E);
    }
    SEAM(8);
    if (IN(9)) {
        const float* gf = args.in[I_GF];
        for (int row = gw; row < NX; row += NGW) {
            const float rs = rsqrtf(__hip_atomic_load(SS3 + row, RLX_AGENT) * (1.f / D) + EPS);
            float* o = args.out + (size_t)row * D;
#pragma unroll
            for (int j = 0; j < 8; ++j) { const int c = 4 * lane + 256 * j; f32x4 v = *(const f32x4*)(o + c); v = (v * rs) * *(const f32x4*)(gf + c); *(f32x4*)(o + c) = v; }
        }
    }
#undef IN
#undef SEAM
}

__global__ void __launch_bounds__(1024) s_mlstm(const bf16* PROJ, const float* gates, const float* gbias, const float* cw, bf16* hf, bf16* hb) {
    __shared__ float q[256], k[256], v[256], n[256], red[16];
    const int dir = blockIdx.x & 1, head = (blockIdx.x >> 1) & 3, b = blockIdx.x >> 3;
    const int tid = threadIdx.x, vv = tid >> 2, dq = tid & 3;
    float C[64];
#pragma unroll
    for (int i = 0; i < 64; ++i) C[i] = 0.f;
    if (tid < 256) n[tid] = 0.f;
    float m = 0.f;
    bf16* out = dir ? hb : hf;
    const int ccol = tid < 256 ? head * 256 + tid : 1024 + head * 256 + (tid - 256);
    float w0 = 0.f, w1 = 0.f, w2 = 0.f; if (tid < 512) { w0 = cw[ccol]; w1 = cw[2048 + ccol]; w2 = cw[4096 + ccol]; }
    __syncthreads();
    for (int step = 0; step < L; ++step) {
        const int p = dir ? (L - 1 - step) : step; const int row = rowof(b, p);
        if (tid < 512) {
            const float xm = p > 0 ? bf2f(PROJ[(size_t)rowof(b, p - 1) * PW + P_MQK + ccol]) : 0.f, x0 = bf2f(PROJ[(size_t)row * PW + P_MQK + ccol]), xp = p < L - 1 ? bf2f(PROJ[(size_t)rowof(b, p + 1) * PW + P_MQK + ccol]) : 0.f;
            const float y = siluf_(xm * w0 + x0 * w1 + xp * w2);
            if (tid < 256) q[tid] = y; else k[tid - 256] = y * 0.0625f;
        } else if (tid < 768) v[tid - 512] = bf2f(PROJ[(size_t)row * PW + P_MV + head * 256 + tid - 512]);
        const float li = gates[(size_t)row * 16 + dir * 8 + head] + gbias[dir * 8 + head];
        const float lf = logsigmoidf_(gates[(size_t)row * 16 + dir * 8 + 4 + head] + gbias[dir * 8 + 4 + head]);
        const float mn = fmaxf(lf + m, li), fd = expf(lf + m - mn), iw = expf(li - mn);
        m = mn;
        __syncthreads();
        const float vi = v[vv] * iw; float part = 0.f;
#pragma unroll
        for (int i = 0; i < 64; ++i) { const int d = dq * 64 + i; C[i] = fd * C[i] + vi * k[d]; part += C[i] * q[d]; }
        part += __shfl_xor(part, 1); part += __shfl_xor(part, 2);
        float dpart = 0.f;
        if (tid < 256) { const float nn = fd * n[tid] + iw * k[tid]; n[tid] = nn; dpart = nn * q[tid]; }
        for (int o = 32; o > 0; o >>= 1) dpart += __shfl_xor(dpart, o);
        if ((tid & 63) == 0) red[tid >> 6] = dpart;
        __syncthreads();
        const float den = red[0] + red[1] + red[2] + red[3];
        if (dq == 0) out[(size_t)row * 1024 + head * 256 + vv] = (bf16)f2bf(part / fmaxf(fabsf(den), expf(-mn)));
        __syncthreads();
    }
}
__device__ __forceinline__ float block_sum256(float v, float* red) {
    for (int o = 32; o > 0; o >>= 1) v += __shfl_xor(v, o);
    __syncthreads();
    if ((threadIdx.x & 63) == 0) red[threadIdx.x >> 6] = v;
    __syncthreads();
    return red[0] + red[1] + red[2] + red[3];
}
__global__ void __launch_bounds__(256) s_mlstm_out(const bf16* hf, const bf16* hb, const bf16* PROJ, const float* ng, bf16* aout) {
    __shared__ float red[8];
    for (int row = blockIdx.x; row < NR; row += gridDim.x)
        for (int head = 0; head < MH; ++head) {
            const size_t o = (size_t)row * 1024 + head * 256 + threadIdx.x;
            const float hs = bf2f(hf[o]) + bf2f(hb[o]);
            const float mu = block_sum256(hs, red) / 256.f; const float dv = hs - mu;
            const float var = block_sum256(dv * dv, red) / 256.f;
            const float mo = bf2f(PROJ[(size_t)row * PW + P_MO + head * 256 + threadIdx.x]);
            aout[o] = (bf16)f2bf(sigmoidf_(mo) * ((dv * rsqrtf(var + EPS)) * ng[head * 256 + threadIdx.x]));
        }
}
__global__ void __launch_bounds__(256) s_attn(const bf16* PROJ, const float* lq1, const float* lk1, const float* lq2, const float* lk2, const float* sg, bf16* bout) {
    extern __shared__ float sm[];
    float* S = sm; float* Q = sm + 2 * 4 * L; float* red = Q + 2 * 4 * 64;
    const int nqb = L / 4;
    float s1 = 0.f, s2 = 0.f; for (int i = 0; i < 64; ++i) { s1 += lq1[i] * lk1[i]; s2 += lq2[i] * lk2[i]; }
    const float lam = expf(s1) - expf(s2) + 0.2f;
    for (int u = blockIdx.x; u < NB * DH * nqb; u += gridDim.x) {
        const int qb = u % nqb, h = (u / nqb) % DH, b = u / (nqb * DH);
        __syncthreads();
        for (int i = threadIdx.x; i < 2 * 4 * 64; i += 256) { const int d = i & 63, qi = (i >> 6) & 3, m = i >> 8;
            Q[i] = bf2f(PROJ[(size_t)rowof(b, qb * 4 + qi) * PW + P_DQ + h * 128 + m * 64 + d]); }
        __syncthreads();
        for (int kk = threadIdx.x; kk < L; kk += 256) {
            const bf16* kr = PROJ + (size_t)rowof(b, kk) * PW + P_DK + h * 128;
            for (int m = 0; m < 2; ++m) { float a[4] = {0.f, 0.f, 0.f, 0.f};
                for (int d = 0; d < 64; ++d) { const float kv = bf2f(kr[m * 64 + d]); for (int qi = 0; qi < 4; ++qi) a[qi] += Q[(m * 4 + qi) * 64 + d] * kv; }
                for (int qi = 0; qi < 4; ++qi) S[(m * 4 + qi) * L + kk] = a[qi] * 0.125f; }
        }
        __syncthreads();
        for (int r = 0; r < 8; ++r) {
            float mx = -1e30f; for (int kk = threadIdx.x; kk < L; kk += 256) mx = fmaxf(mx, S[r * L + kk]);
            for (int o = 32; o > 0; o >>= 1) mx = fmaxf(mx, __shfl_xor(mx, o));
            __syncthreads(); if ((threadIdx.x & 63) == 0) red[threadIdx.x >> 6] = mx; __syncthreads();
            mx = fmaxf(fmaxf(red[0], red[1]), fmaxf(red[2], red[3]));
            float sum = 0.f; for (int kk = threadIdx.x; kk < L; kk += 256) { const float e = expf(S[r * L + kk] - mx); S[r * L + kk] = e; sum += e; }
            for (int o = 32; o > 0; o >>= 1) sum += __shfl_xor(sum, o);
            __syncthreads(); if ((threadIdx.x & 63) == 0) red[threadIdx.x >> 6] = sum; __syncthreads();
            const float inv = 1.f / (red[0] + red[1] + red[2] + red[3]);
            for (int kk = threadIdx.x; kk < L; kk += 256) S[r * L + kk] *= inv;
        }
        __syncthreads();
        for (int i = threadIdx.x; i < 4 * L; i += 256) S[i] = S[i] - lam * S[4 * L + i];
        __syncthreads();
        const int qi = threadIdx.x >> 6, c2 = (threadIdx.x & 63) * 2;
        float o0 = 0.f, o1 = 0.f;
        for (int kk = 0; kk < L; ++kk) { const float a = S[qi * L + kk]; const unsigned vw = *(const unsigned*)(PROJ + (size_t)rowof(b, kk) * PW + P_DV + h * 128 + c2); o0 += a * bflo(vw); o1 += a * bfhi(vw); }
        float ss = o0 * o0 + o1 * o1; for (int o = 32; o > 0; o >>= 1) ss += __shfl_xor(ss, o);
        const float r = rsqrtf(ss / 128.f + EPS);
        *(unsigned*)(bout + (size_t)rowof(b, qb * 4 + qi) * 1024 + h * 128 + c2) = pk2((o0 * r) * sg[c2] * 0.8f, (o1 * r) * sg[c2 + 1] * 0.8f);
    }
}
__global__ void __launch_bounds__(256) s_convglu(const bf16* UP, const float* fw, bf16* act) {
    for (size_t i = (size_t)blockIdx.x * 256 + threadIdx.x; i < (size_t)NX * FFN; i += (size_t)gridDim.x * 256) {
        const int row = (int)(i / FFN), c = (int)(i % FFN); int b, p; row2bp(row, b, p);
        const size_t rm = (size_t)rowof(b, p - 1) * PW, r0 = (size_t)row * PW, rp = p < L - 1 ? (size_t)rowof(b, p + 1) * PW : 0;
        const float gm = bf2f(UP[rm + c]), g0 = bf2f(UP[r0 + c]), gp = p < L - 1 ? bf2f(UP[rp + c]) : 0.f;
        const float vm = bf2f(UP[rm + FFN + c]), v0 = bf2f(UP[r0 + FFN + c]), vp = p < L - 1 ? bf2f(UP[rp + FFN + c]) : 0.f;
        const float cg = gm * fw[c] + g0 * fw[2 * FFN + c] + gp * fw[4 * FFN + c];
        const float cv = vm * fw[FFN + c] + v0 * fw[2 * FFN + FFN + c] + vp * fw[4 * FFN + FFN + c];
        act[i] = (bf16)f2bf(siluf_(cg) * cv);
    }
}

extern "C" void kernel_launch(void* const* d_in, const int* in_sizes, int n_in, void* d_out, int out_size, void* d_ws, size_t ws_size, hipStream_t stream) {
    static int grid = 0;
    constexpr int ATT_LDS = (2 * 4 * L + 2 * 4 * 64 + 16) * 4;
    if (grid == 0) {
        if (n_in != 20 || ws_size < WS_END || out_size != NX * D) { fprintf(stderr, "kernel_launch: n_in %d ws %zu (need %zu) out %d\n", n_in, ws_size, (size_t)WS_END, out_size); grid = -1; return; }
        int dev = 0, cus = 0;
        if (hipGetDevice(&dev) != hipSuccess || hipDeviceGetAttribute(&cus, hipDeviceAttributeMultiprocessorCount, dev) != hipSuccess) { grid = -1; return; }
        if (hipFuncSetAttribute((const void*)mk_fwd, hipFuncAttributeMaxDynamicSharedMemorySize, LDS_BYTES) != hipSuccess) { fprintf(stderr, "kernel_launch: LDS attr failed\n"); grid = -1; return; }
        if (hipFuncSetAttribute((const void*)s_attn, hipFuncAttributeMaxDynamicSharedMemorySize, ATT_LDS) != hipSuccess) { grid = -1; return; }
        grid = cus;
    }
    if (grid < 0) return;
    (void)hipMemsetAsync((char*)d_ws + WS_CTL, 0, CTL_ZERO_BYTES, stream);
    Args a{};
    for (int i = 0; i < 20; ++i) a.in[i] = (const float*)d_in[i];
    a.out = (float*)d_out; a.ws = (unsigned char*)d_ws;
    unsigned char* ws = (unsigned char*)d_ws;
    const bf16* PROJ = (const bf16*)(ws + WS_P); bf16* HF = (bf16*)(ws + WS_X); bf16* HB = HF + (size_t)MP * 1024; bf16* AOUT = (bf16*)(ws + WS_A); bf16* BOUT = AOUT + (size_t)MP * 1024;
#define FRAME(lo_, hi_) do { a.ph_lo = (lo_); a.ph_hi = (hi_); hipLaunchKernelGGL(mk_fwd, dim3(grid), dim3(NWAVES * 64), LDS_BYTES, stream, a); } while (0)
#if MK_ONE_LAUNCH
    FRAME(0, N_PHASES);
#else
    for (int ph = 0; ph < N_PHASES; ++ph) FRAME(ph, ph + 1);
#endif
    const hipError_t le = hipPeekAtLastError();
    if (le != hipSuccess) fprintf(stderr, "kernel_launch: launch failed: %s\n", hipGetErrorName(le));
}
```
